# Optimizing an MI355X kernel written in HIP

```python
import jax, jax.numpy as jnp
from jax import lax
import numpy as np

D_MODEL = 1024
BATCH = 4
SEQ = 4096
DEPTH = 4

GRID_W = 64
CTX_LEN = 256
N_MIXERS = 2
CHUNK = 128
A_WIDTH = 2 * D_MODEL
A_GROUPS = 8
A_GW = A_WIDTH // A_GROUPS
HEAD_DIM = 64
N_HEADS = D_MODEL // HEAD_DIM
N_KV_HEADS = N_HEADS // 4
GQA_GROUP = N_HEADS // N_KV_HEADS
B_WIDTH = N_HEADS * HEAD_DIM
KV_WIDTH = N_KV_HEADS * HEAD_DIM
WINDOW = 128
ATT_BLOCK = 128
BAND = ATT_BLOCK + 2 * WINDOW
ROPE_AXIS_DIM = HEAD_DIM // 2
ROPE_BASE = 10000.0
LN_EPS = 1e-5
NEG_INF = -1e30

kernel_name = "hybrid_gmlp_swa_prefix_dit"


def layer_norm(x, g, b):
    xf = x.astype(jnp.float32)
    mu = jnp.mean(xf, axis=-1, keepdims=True)
    var = jnp.mean(jnp.square(xf - mu), axis=-1, keepdims=True)
    y = (xf - mu) * lax.rsqrt(var + LN_EPS) * g.astype(jnp.float32) + b.astype(jnp.float32)
    return y.astype(x.dtype)


def chunk_spatial_mix(v, w_s, b_s):
    bsz, length, _ = v.shape
    vc = v.reshape(bsz, length // CHUNK, CHUNK, A_GROUPS, A_GW)
    s = jnp.einsum('gpq,bnqgc->bnpgc', w_s, vc) + b_s.T[None, None, :, :, None]
    return s.reshape(bsz, length, A_WIDTH)


def mixer_a(h, w_in, ln_g, ln_b, w_s, b_s, w_out):
    u, v, z = jnp.split(h @ w_in, 3, axis=-1)
    u = jax.nn.gelu(u)
    v = layer_norm(jax.nn.gelu(v), ln_g, ln_b)
    y = u * chunk_spatial_mix(v, w_s, b_s)
    return (y * jax.nn.silu(z)) @ w_out


def axial_rope_angles(length):
    rows = length // GRID_W
    row = jnp.repeat(jnp.arange(rows), GRID_W).astype(jnp.float32)
    col = jnp.tile(jnp.arange(GRID_W), rows).astype(jnp.float32)
    n_freq = ROPE_AXIS_DIM // 2
    inv = ROPE_BASE ** (-jnp.arange(n_freq, dtype=jnp.float32) / n_freq)
    return row[:, None] * inv[None, :], col[:, None] * inv[None, :]


def rotate_axis(x, ang):
    x1, x2 = jnp.split(x, 2, axis=-1)
    cos = jnp.cos(ang)[None, :, None, :].astype(x.dtype)
    sin = jnp.sin(ang)[None, :, None, :].astype(x.dtype)
    return jnp.concatenate([x1 * cos - x2 * sin, x2 * cos + x1 * sin], axis=-1)


def apply_axial_rope(x, ang_row, ang_col):
    xr, xc = jnp.split(x, 2, axis=-1)
    return jnp.concatenate([rotate_axis(xr, ang_row), rotate_axis(xc, ang_col)], axis=-1)


def project_qkvz(h, w_in):
    bsz, length, _ = h.shape
    q, k, v, z = jnp.split(h @ w_in, [B_WIDTH, B_WIDTH + KV_WIDTH, B_WIDTH + 2 * KV_WIDTH], axis=-1)
    return (q.reshape(bsz, length, N_HEADS, HEAD_DIM),
            k.reshape(bsz, length, N_KV_HEADS, HEAD_DIM),
            v.reshape(bsz, length, N_KV_HEADS, HEAD_DIM), z)


def project_kv(h, w_in):
    bsz, length, _ = h.shape
    k, v = jnp.split(h @ w_in[:, B_WIDTH:B_WIDTH + 2 * KV_WIDTH], 2, axis=-1)
    return (k.reshape(bsz, length, N_KV_HEADS, HEAD_DIM),
            v.reshape(bsz, length, N_KV_HEADS, HEAD_DIM))


def windowed_attention_with_context(q, k, v, k_ctx, v_ctx, sink):
    bsz, length = q.shape[:2]
    n_ctx = k_ctx.shape[1]
    nb = length // ATT_BLOCK
    scale = HEAD_DIM ** -0.5
    qg = q.reshape(bsz, length, N_KV_HEADS, GQA_GROUP, HEAD_DIM)
    pad = ((0, 0), (WINDOW, WINDOW), (0, 0), (0, 0))
    k_pad = jnp.pad(k, pad)
    v_pad = jnp.pad(v, pad)
    sink_l = sink.astype(jnp.float32).reshape(1, N_KV_HEADS, GQA_GROUP, 1, 1)
    qi = jnp.arange(ATT_BLOCK)[:, None]
    kj = jnp.arange(BAND)[None, :]
    rel = kj - WINDOW - qi

    def block(i):
        start = i * ATT_BLOCK
        qb = lax.dynamic_slice_in_dim(qg, start, ATT_BLOCK, axis=1)
        kb = lax.dynamic_slice_in_dim(k_pad, start, BAND, axis=1)
        vb = lax.dynamic_slice_in_dim(v_pad, start, BAND, axis=1)
        key_pos = start - WINDOW + kj
        valid = (jnp.abs(rel) <= WINDOW) & (key_pos >= 0) & (key_pos < length)
        s_loc = jnp.einsum('bqhgd,bkhd->bhgqk', qb, kb).astype(jnp.float32) * scale
        s_loc = jnp.where(valid, s_loc, NEG_INF)
        s_ctx = jnp.einsum('bqhgd,bkhd->bhgqk', qb, k_ctx).astype(jnp.float32) * scale
        s_sink = jnp.broadcast_to(sink_l, s_loc.shape[:-1] + (1,))
        p = jax.nn.softmax(jnp.concatenate([s_loc, s_ctx, s_sink], axis=-1), axis=-1)
        p_loc = p[..., :BAND].astype(v.dtype)
        p_ctx = p[..., BAND:BAND + n_ctx].astype(v.dtype)
        return (jnp.einsum('bhgqk,bkhd->bqhgd', p_loc, vb)
                + jnp.einsum('bhgqk,bkhd->bqhgd', p_ctx, v_ctx))

    out = lax.map(block, jnp.arange(nb))
    return jnp.moveaxis(out, 0, 1).reshape(bsz, length, B_WIDTH)


def context_attention(q_ctx, k_ctx, v_ctx, sink):
    bsz, n_ctx = q_ctx.shape[:2]
    scale = HEAD_DIM ** -0.5
    qg = q_ctx.reshape(bsz, n_ctx, N_KV_HEADS, GQA_GROUP, HEAD_DIM)
    s = jnp.einsum('bqhgd,bkhd->bhgqk', qg, k_ctx).astype(jnp.float32) * scale
    s_sink = jnp.broadcast_to(sink.astype(jnp.float32).reshape(1, N_KV_HEADS, GQA_GROUP, 1, 1),
                              s.shape[:-1] + (1,))
    p = jax.nn.softmax(jnp.concatenate([s, s_sink], axis=-1), axis=-1)
    o = jnp.einsum('bhgqk,bkhd->bqhgd', p[..., :n_ctx].astype(v_ctx.dtype), v_ctx)
    return o.reshape(bsz, n_ctx, B_WIDTH)


def mixer_b(h, hc, w_in, sink, w_out, ang_row, ang_col, need_ctx_out):
    q, k, v, z = project_qkvz(h, w_in)
    q = apply_axial_rope(q, ang_row, ang_col)
    k = apply_axial_rope(k, ang_row, ang_col)
    if need_ctx_out:
        qc, kc, vc, zc = project_qkvz(hc, w_in)
    else:
        kc, vc = project_kv(hc, w_in)
    o = windowed_attention_with_context(q, k, v, kc, vc, sink)
    out = (o * jax.nn.silu(z)) @ w_out
    out_c = None
    if need_ctx_out:
        oc = context_attention(qc, kc, vc, sink)
        out_c = (oc * jax.nn.silu(zc)) @ w_out
    return out, out_c


def setup_inputs(seed: int = 0) -> dict:
    key = jax.random.key(seed)
    ks = jax.random.split(key, 20)
    n_a = (DEPTH + N_MIXERS - 1) // N_MIXERS
    n_b = DEPTH // N_MIXERS
    beta = (8.0 * DEPTH) ** -0.25
    nrm = jax.random.normal
    f32 = jnp.float32
    return {
        "x": nrm(ks[0], (BATCH, SEQ, D_MODEL), f32),
        "c": nrm(ks[1], (BATCH, D_MODEL), f32),
        "ctx": nrm(ks[2], (BATCH, CTX_LEN, D_MODEL), f32),
        "c_ctx": nrm(ks[3], (D_MODEL,), f32),
        "ada_w": nrm(ks[4], (DEPTH, D_MODEL, 3 * D_MODEL), f32) * (0.5 * D_MODEL ** -0.5),
        "ada_b": nrm(ks[5], (DEPTH, 3 * D_MODEL), f32) * 0.01,
        "ln_g": 1.0 + 0.05 * nrm(ks[6], (DEPTH, D_MODEL), f32),
        "ln_b": 0.01 * nrm(ks[7], (DEPTH, D_MODEL), f32),
        "a_w_in": nrm(ks[8], (n_a, D_MODEL, 3 * A_WIDTH), f32) * D_MODEL ** -0.5,
        "a_ln_g": 1.0 + 0.05 * nrm(ks[9], (n_a, A_WIDTH), f32),
        "a_ln_b": 0.01 * nrm(ks[10], (n_a, A_WIDTH), f32),
        "a_w_s": nrm(ks[11], (n_a, A_GROUPS, CHUNK, CHUNK), f32) * CHUNK ** -0.5,
        "a_b_s": 1.0 + 0.05 * nrm(ks[12], (n_a, A_GROUPS, CHUNK), f32),
        "a_w_out": nrm(ks[13], (n_a, A_WIDTH, D_MODEL), f32) * (A_WIDTH ** -0.5 * beta),
        "b_w_in": nrm(ks[14], (n_b, D_MODEL, 2 * B_WIDTH + 2 * KV_WIDTH), f32) * D_MODEL ** -0.5,
        "b_sink": 0.5 * nrm(ks[15], (n_b, N_HEADS), f32),
        "b_w_out": nrm(ks[16], (n_b, B_WIDTH, D_MODEL), f32) * (B_WIDTH ** -0.5 * beta),
    }


def reference(x, c, ctx, c_ctx, ada_w, ada_b, ln_g, ln_b,
              a_w_in, a_ln_g, a_ln_b, a_w_s, a_b_s, a_w_out,
              b_w_in, b_sink, b_w_out):
    alpha = (2.0 * DEPTH) ** 0.25
    length = x.shape[1]
    ang_row, ang_col = axial_rope_angles(length)
    cond = jax.nn.silu(c)
    cond_ctx = jax.nn.silu(c_ctx)
    for i in range(DEPTH):
        j = i // N_MIXERS
        need_ctx_out = i < DEPTH - 1
        shift, scale, gate = jnp.split(cond @ ada_w[i] + ada_b[i], 3, axis=-1)
        shift_c, scale_c, gate_c = jnp.split(cond_ctx @ ada_w[i] + ada_b[i], 3, axis=-1)
        h = x * (1.0 + scale[:, None, :]) + shift[:, None, :]
        hc = ctx * (1.0 + scale_c) + shift_c
        if i % N_MIXERS == 0:
            out = mixer_a(h, a_w_in[j], a_ln_g[j], a_ln_b[j], a_w_s[j], a_b_s[j], a_w_out[j])
            out_c = (mixer_a(hc, a_w_in[j], a_ln_g[j], a_ln_b[j], a_w_s[j], a_b_s[j], a_w_out[j])
                     if need_ctx_out else None)
        else:
            out, out_c = mixer_b(h, hc, b_w_in[j], b_sink[j], b_w_out[j], ang_row, ang_col, need_ctx_out)
        x = layer_norm(alpha * x + gate[:, None, :] * out, ln_g[i], ln_b[i])
        if need_ctx_out:
            ctx = layer_norm(alpha * ctx + gate_c * out_c, ln_g[i], ln_b[i])
    return x
```

```cpp
#include <hip/hip_runtime.h>
#include <hip/hip_cooperative_groups.h>
#include <cstdio>
#include <cstdint>
#ifndef REPN_G1A
#define REPN_G1A 1
#endif
#ifndef REPN_G1B
#define REPN_G1B 1
#endif

namespace cg = cooperative_groups;
#define LAS __attribute__((address_space(3)))
#define DI __device__ __forceinline__
typedef unsigned short bf16_t;
typedef short bf16x8 __attribute__((ext_vector_type(8)));
typedef short s16x4 __attribute__((ext_vector_type(4)));
typedef float f32x2 __attribute__((ext_vector_type(2)));
typedef float f32x4 __attribute__((ext_vector_type(4)));
typedef float f32x16 __attribute__((ext_vector_type(16)));
typedef unsigned u32x2 __attribute__((ext_vector_type(2)));
typedef unsigned u32x4 __attribute__((ext_vector_type(4)));
typedef __bf16 bf16x2_t __attribute__((ext_vector_type(2)));

constexpr int DM = 1024, NB = 4, SEQ = 4096, TL = NB * SEQ, CL = 256, TC = NB * CL, T = TL + TC;
constexpr int AW = 2048;
constexpr float LN_EPS = 1e-5f;
constexpr float ALPHA = 1.681792830507429f;
constexpr float LOG2E = 1.4426950408889634f;
constexpr int NTHREADS = 512, NWAVES = 8;
constexpr int LDS_BYTES = 147456;

constexpr size_t MiB = 1u << 20;
constexpr size_t WS_MOD = 0;
constexpr size_t WS_ROPE = 262144;
constexpr size_t WS_STAT = 524288;
constexpr size_t WS_BAR = 2883584;
constexpr size_t WS_RSTAT = WS_BAR + 16384;
constexpr size_t WS_XC = 3 * MiB;
constexpr size_t WS_W = 7 * MiB;
constexpr size_t WA_UZ = 0, WA_V = 8 * MiB, WA_OUT = 12 * MiB, WA_S = 16 * MiB, WA_SIZE = 16 * MiB + 262144;
constexpr size_t WB_QKZ = 0, WB_V = 4 * MiB + 524288, WB_OUT = 5 * MiB, WB_SIZE = 7 * MiB;
constexpr size_t WS_WA0 = WS_W, WS_WB0 = WS_W + 2 * WA_SIZE;
constexpr size_t WS_H = 54 * MiB;
constexpr size_t WS_ACT = 88 * MiB;
constexpr size_t ACT_UZ = 0, ACT_VTA = 68 * MiB;
constexpr size_t ACT_Q = 0, ACT_K = 34 * MiB, ACT_VTB = 34 * MiB + 8912896, ACT_Z = 52 * MiB, ACT_OZ = 86 * MiB;
constexpr size_t WS_END = 224 * MiB;
static_assert(WS_WB0 + 2 * WB_SIZE <= WS_H, "weights fit");
static_assert((size_t)T * 256 * 2 == 8912896, "kv size");
static_assert(ACT_VTB + 8912896 <= ACT_Z && ACT_OZ + 34 * MiB <= 136 * MiB, "act map");

DI unsigned cvtpk(float lo, float hi) { f32x2 v = {lo, hi}; bf16x2_t b = __builtin_convertvector(v, bf16x2_t); return __builtin_bit_cast(unsigned, b); }
DI float bflo(unsigned u) { return __uint_as_float(u << 16); }
DI float bfhi(unsigned u) { return __uint_as_float(u & 0xffff0000u); }
DI float fast_sigmoid(float t) { return __builtin_amdgcn_rcpf(1.0f + __builtin_amdgcn_exp2f(-LOG2E * t)); }
DI float gelu_t(float x) { const float t = x * (1.5957691216057308f + 0.07135481627183409f * x * x); return x * fast_sigmoid(t); }
DI float silu_f(float x) { return x * fast_sigmoid(x); }
typedef _Float16 h16x2 __attribute__((ext_vector_type(2)));
DI unsigned pkh(float lo, float hi) { const h16x2 v = {(_Float16)lo, (_Float16)hi}; return __builtin_bit_cast(unsigned, v); }
DI float hlo(unsigned u) { return (float)__builtin_bit_cast(h16x2, u).x; }
DI float hhi(unsigned u) { return (float)__builtin_bit_cast(h16x2, u).y; }
DI int opaque_tid() { int t = threadIdx.x; asm volatile("" : "+v"(t)); return t; }
template <int CTRL> DI float dpp_add(float v) { return v + __builtin_bit_cast(float, __builtin_amdgcn_update_dpp(0, __builtin_bit_cast(int, v), CTRL, 0xf, 0xf, false)); }
DI float max3f(float a, float b, float c) { float r; asm("v_max3_f32 %0, %1, %2, %3" : "=v"(r) : "v"(a), "v"(b), "v"(c)); return r; }
DI f32x2 exp2_2(f32x2 v) { return (f32x2){__builtin_amdgcn_exp2f(v.x), __builtin_amdgcn_exp2f(v.y)}; }
DI f32x2 rcp_2(f32x2 v) { return (f32x2){__builtin_amdgcn_rcpf(v.x), __builtin_amdgcn_rcpf(v.y)}; }
constexpr float GELU_A = -1.5957691216057308f * LOG2E, GELU_B = -0.07135481627183409f * LOG2E;
DI f32x2 gelu_silu_pk(f32x2 u, f32x2 z) { const f32x2 p = (u * u) * GELU_B + GELU_A; const f32x2 e1 = exp2_2(u * p), e2 = exp2_2(z * (-LOG2E)); return (u * z) * rcp_2((e1 + 1.0f) * (e2 + 1.0f)); }
DI f32x2 gelu_pk2(f32x2 u) { const f32x2 p = (u * u) * GELU_B + GELU_A; return u * rcp_2(exp2_2(u * p) + 1.0f); }
DI f32x2 silu_pk2(f32x2 z) { return z * rcp_2(exp2_2(z * (-LOG2E)) + 1.0f); }
DI float xhalf_f(float v) { const unsigned u = __builtin_bit_cast(unsigned, v);
#if __has_builtin(__builtin_amdgcn_permlane32_swap)
    const auto r = __builtin_amdgcn_permlane32_swap(u, u, false, false); const unsigned lo = r[0], hi = r[1];
    return __builtin_bit_cast(float, (threadIdx.x & 32) ? lo : hi);
#else
    return __shfl_xor(v, 32);
#endif
}
DI float wave_sum_dpp(float v) {
    v = dpp_add<0xB1>(v); v = dpp_add<0x4E>(v); v = dpp_add<0x141>(v); v = dpp_add<0x140>(v);
    v += __shfl_xor(v, 16); v += __shfl_xor(v, 32);
    return v;
}
DI float wave_sum(float v) {
#pragma unroll
    for (int o = 1; o < 64; o <<= 1) v += __shfl_xor(v, o);
    return v;
}

namespace pg8 {
#define PG8_LAS __attribute__((address_space(3)))
constexpr int BM = 256, BK = 64, HALF = 128, HTB = HALF * BK * 2, STAGE_BYTES = 8 * HTB, NXCD = 8, WGM = 8;
__host__ __device__ __forceinline__ int lds_byte(int r, int c) { const int st = (r >> 4) * 2 + (c >> 5), rr = r & 15, cc = c & 31, ob = rr * 64 + cc * 2; return st * 1024 + (ob ^ (((ob >> 9) & 1) << 5)); }
__host__ __device__ __forceinline__ void stage_rc(int b, int& R, int& C) { const int st = b / 1024, sb = b % 1024, swz = sb ^ (((sb >> 9) & 1) << 5); R = (st >> 1) * 16 + swz / 64; C = (st & 1) * 32 + (swz % 64) / 2; }
__host__ __device__ __forceinline__ int perm32(int rho) { const int n = rho >> 4, i = rho & 15; return 8 * (i >> 2) + 4 * n + (i & 3); }

struct Unit { int pm, pn; };

struct VSched {
    int nM, nN, nwg, G, c, nsplit; const char* A0; const char* B0; const char* A1; size_t tstep;
    DI void init(int nM_, int nN_, int nsplit_, int G_, int c_, const void* a0, const void* b0, const void* a1, int K) {
        nM = nM_; nN = nN_; nwg = nM * nN; G = G_; c = c_; nsplit = nsplit_; A0 = (const char*)a0; B0 = (const char*)b0; A1 = (const char*)a1; tstep = (size_t)BM * K * 2; }
    DI bool next(int i, Unit& u) const {
        const long L = (long)i * G + c; if (L >= nwg) return false;
        int wgid = (int)L; { const int q = nwg / NXCD, r = nwg % NXCD, xcd = wgid % NXCD, off = wgid / NXCD; wgid = (xcd < r ? xcd * (q + 1) : r * (q + 1) + (xcd - r) * q) + off; }
        const int nig = WGM * nN, gid = wgid / nig, fm = gid * WGM, gsz = (nM - fm) < WGM ? (nM - fm) : WGM;
        u.pm = fm + ((wgid % nig) % gsz); u.pn = (wgid % nig) / gsz; return true;
    }
    DI const char* pa(const Unit& u) const { return u.pn < nsplit ? A0 + (size_t)u.pm * tstep : A1 + (size_t)(u.pn - nsplit) * tstep; }
    DI const char* pb(const Unit& u) const { return u.pn < nsplit ? B0 + (size_t)u.pn * tstep : A0 + (size_t)u.pm * tstep; }
};

template <class Epi, bool ALIGN_EPI, bool SP2>
__device__ __forceinline__ void gemm_phase(PG8_LAS unsigned char* lds, const int K, const VSched& S, const Epi& E) {
    const int tid = opaque_tid(), wid = __builtin_amdgcn_readfirstlane(tid >> 6), lane = tid & 63, wr = wid >> 2, wc = wid & 3, fr = lane & 15, fq = lane >> 4;
    const int nt = K / BK;
    unsigned voffA[2], voffB[2];
#pragma unroll
    for (int i = 0; i < 2; ++i) { int R, C; stage_rc(tid * 16 + i * 8192, R, C); const int Rb = Epi::PERM ? ((R & ~31) + perm32(R & 31)) : R;
        voffA[i] = (unsigned)(R * K + C) * 2u; voffB[i] = (unsigned)(Rb * K + C) * 2u; }
    const size_t kstep = (size_t)(BK * 2);
    const size_t hstep = (size_t)HALF * K * 2;
    const unsigned ldsw = (unsigned)wid * 1024u;
    const int aoff = lds_byte(wr * 64 + fr, fq * 8), boff = lds_byte(wc * 32 + fr, fq * 8);
#define PG8_SA(b, h) (((b) * 2 + (h)) * HTB)
#define PG8_SB(b, h) ((4 + (b) * 2 + (h)) * HTB)
#define PG8_STAGE(bufoff, gbase, voff) do { _Pragma("unroll") for (int _i = 0; _i < 2; ++_i) \
        __builtin_amdgcn_global_load_lds((const unsigned*)((const char*)(gbase) + (voff)[_i]), (PG8_LAS unsigned*)(lds + (bufoff) + ldsw + _i * 8192), 16, 0, 0); } while (0)
#define PG8_LDA(dst, b, h) do { _Pragma("unroll") for (int m = 0; m < 4; ++m) _Pragma("unroll") for (int k = 0; k < 2; ++k) dst[m][k] = *(const PG8_LAS bf16x8*)(lds + PG8_SA(b, h) + aoff + m * 2048 + k * 1024); } while (0)
#define PG8_LDB(dst, b, h) do { _Pragma("unroll") for (int n = 0; n < 2; ++n) _Pragma("unroll") for (int k = 0; k < 2; ++k) dst[n][k] = *(const PG8_LAS bf16x8*)(lds + PG8_SB(b, h) + boff + n * 2048 + k * 1024); } while (0)
#define PG8_MMA(ai, bj, At, Bt) do { __builtin_amdgcn_s_setprio(1); _Pragma("unroll") for (int m = 0; m < 4; ++m) _Pragma("unroll") for (int n = 0; n < 2; ++n) _Pragma("unroll") for (int k = 0; k < 2; ++k) \
        acc[ai][bj][m][n] = __builtin_amdgcn_mfma_f32_16x16x32_bf16(Bt[n][k], At[m][k], acc[ai][bj][m][n], 0, 0, 0); __builtin_amdgcn_s_setprio(0); } while (0)
#define PG8_WAIT_V(n) asm volatile("s_waitcnt vmcnt(" #n ")" ::: "memory")
#define PG8_WAIT_L(n) asm volatile("s_waitcnt lgkmcnt(" #n ")" ::: "memory")
#define PG8_BAR __builtin_amdgcn_s_barrier()
#define PG8_SCHED __builtin_amdgcn_sched_barrier(0)
    Unit cur, nxt; int ui = 0;
    if (!S.next(0, cur)) return;
    f32x4 acc[2][2][4][2];
#pragma unroll
    for (int a = 0; a < 2; ++a)
#pragma unroll
        for (int b = 0; b < 2; ++b)
#pragma unroll
            for (int m = 0; m < 4; ++m)
#pragma unroll
                for (int n = 0; n < 2; ++n) acc[a][b][m][n] = (f32x4){0.f, 0.f, 0.f, 0.f};
    bf16x8 At[4][2], B0[2][2], B1[2][2];
    const char* cA = S.pa(cur); const char* cB = S.pb(cur);
    if constexpr (SP2) {
        PG8_STAGE(PG8_SB(0, 0), cB, voffB); PG8_STAGE(PG8_SB(0, 1), cB + hstep, voffB); PG8_STAGE(PG8_SA(0, 0), cA, voffA); PG8_STAGE(PG8_SA(0, 1), cA + hstep, voffA);
        if (wr == 1) PG8_BAR;
        PG8_WAIT_V(2); PG8_BAR;
        PG8_STAGE(PG8_SB(1, 0), cB + kstep, voffB); PG8_STAGE(PG8_SA(1, 0), cA + kstep, voffA); PG8_STAGE(PG8_SB(1, 1), cB + hstep + kstep, voffB);
        PG8_WAIT_V(6); PG8_BAR;
    } else {
        PG8_STAGE(PG8_SB(0, 0), cB, voffB); PG8_STAGE(PG8_SA(0, 0), cA, voffA); PG8_STAGE(PG8_SB(0, 1), cB + hstep, voffB); PG8_STAGE(PG8_SA(0, 1), cA + hstep, voffA);
        if (wr == 1) PG8_BAR;
        PG8_WAIT_V(4); PG8_BAR;
        PG8_STAGE(PG8_SB(1, 0), cB + kstep, voffB); PG8_STAGE(PG8_SA(1, 0), cA + kstep, voffA); PG8_STAGE(PG8_SB(1, 1), cB + hstep + kstep, voffB);
        PG8_WAIT_V(6); PG8_BAR;
    }
    for (;;) {
        const bool has_next = S.next(ui + 1, nxt);
        const char* nA = has_next ? S.pa(nxt) : cA; const char* nB = has_next ? S.pb(nxt) : cB;
        for (int t = 0; t < nt; t += 2) {
            const bool last = (t == nt - 2);
            const char* a1 = cA + (size_t)(t + 1) * kstep;
            const char* a2 = last ? nA : cA + (size_t)(t + 2) * kstep; const char* b2 = last ? nB : cB + (size_t)(t + 2) * kstep;
            const char* a3 = a2 + kstep; const char* b3 = b2 + kstep;
            if constexpr (SP2) {
            PG8_LDB(B0, 0, 0); PG8_LDB(B1, 0, 1); PG8_SCHED; PG8_LDA(At, 0, 0); PG8_STAGE(PG8_SA(1, 1), a1 + hstep, voffA);
            PG8_WAIT_V(8); PG8_WAIT_L(0); PG8_BAR; PG8_MMA(0, 0, At, B0); PG8_MMA(0, 1, At, B1); PG8_BAR; PG8_SCHED;
            PG8_LDA(At, 0, 1); PG8_STAGE(PG8_SB(0, 0), b2, voffB); PG8_STAGE(PG8_SB(0, 1), b2 + hstep, voffB); PG8_STAGE(PG8_SA(0, 0), a2, voffA);
            PG8_WAIT_V(8); PG8_WAIT_L(0); PG8_BAR; PG8_MMA(1, 0, At, B0); PG8_MMA(1, 1, At, B1); PG8_BAR; PG8_SCHED;
            PG8_LDB(B0, 1, 0); PG8_LDB(B1, 1, 1); PG8_SCHED; PG8_LDA(At, 1, 0); PG8_STAGE(PG8_SA(0, 1), a2 + hstep, voffA);
            PG8_WAIT_V(8); PG8_WAIT_L(0); PG8_BAR; PG8_MMA(0, 0, At, B0); PG8_MMA(0, 1, At, B1); PG8_BAR; PG8_SCHED;
            PG8_LDA(At, 1, 1); PG8_STAGE(PG8_SB(1, 0), b3, voffB); PG8_STAGE(PG8_SB(1, 1), b3 + hstep, voffB); PG8_STAGE(PG8_SA(1, 0), a3, voffA);
            PG8_WAIT_V(8); PG8_WAIT_L(0); PG8_BAR; PG8_MMA(1, 0, At, B0); PG8_MMA(1, 1, At, B1); PG8_BAR; PG8_SCHED;
            } else {
            PG8_LDB(B0, 0, 0); PG8_SCHED; PG8_LDA(At, 0, 0); PG8_STAGE(PG8_SA(1, 1), a1 + hstep, voffA);
            PG8_WAIT_L(8); PG8_BAR; PG8_WAIT_L(0); PG8_MMA(0, 0, At, B0); PG8_BAR; PG8_SCHED;
            PG8_LDB(B1, 0, 1); PG8_STAGE(PG8_SB(0, 0), b2, voffB);
            PG8_BAR; PG8_WAIT_L(0); PG8_MMA(0, 1, At, B1); PG8_BAR;
            PG8_LDA(At, 0, 1); PG8_STAGE(PG8_SA(0, 0), a2, voffA);
            PG8_BAR; PG8_WAIT_L(0); PG8_MMA(1, 0, At, B0); PG8_BAR; PG8_SCHED;
            PG8_STAGE(PG8_SB(0, 1), b2 + hstep, voffB);
            PG8_WAIT_V(6); PG8_BAR; PG8_MMA(1, 1, At, B1); PG8_BAR;
            PG8_LDB(B0, 1, 0); PG8_SCHED; PG8_LDA(At, 1, 0); PG8_STAGE(PG8_SA(0, 1), a2 + hstep, voffA);
            PG8_WAIT_L(8); PG8_BAR; PG8_WAIT_L(0); PG8_MMA(0, 0, At, B0); PG8_BAR; PG8_SCHED;
            PG8_LDB(B1, 1, 1); PG8_STAGE(PG8_SB(1, 0), b3, voffB);
            PG8_BAR; PG8_WAIT_L(0); PG8_MMA(0, 1, At, B1); PG8_BAR;
            PG8_LDA(At, 1, 1); PG8_STAGE(PG8_SA(1, 0), a3, voffA);
            PG8_BAR; PG8_WAIT_L(0); PG8_MMA(1, 0, At, B0); PG8_BAR; PG8_SCHED;
            PG8_STAGE(PG8_SB(1, 1), b3 + hstep, voffB);
            PG8_WAIT_V(6); PG8_BAR; PG8_MMA(1, 1, At, B1); PG8_BAR;
            }
        }
        if constexpr (ALIGN_EPI) { if (wr == 0) PG8_BAR; }
        { int fr2 = fr, fq2 = fq; asm volatile("" : "+v"(fr2), "+v"(fq2)); E(acc, cur, wr, wc, fr2, fq2); }
        if (!has_next) break;
#pragma unroll
        for (int a = 0; a < 2; ++a)
#pragma unroll
            for (int b = 0; b < 2; ++b)
#pragma unroll
                for (int m = 0; m < 4; ++m)
#pragma unroll
                    for (int n = 0; n < 2; ++n) acc[a][b][m][n] = (f32x4){0.f, 0.f, 0.f, 0.f};
        cur = nxt; cA = nA; cB = nB; ++ui;
        if constexpr (ALIGN_EPI) { if (wr == 1) PG8_BAR; }
    }
    PG8_WAIT_V(0);
    if constexpr (!ALIGN_EPI) { if (wr == 0) PG8_BAR; }
    PG8_BAR;
#undef PG8_SA
#undef PG8_SB
#undef PG8_STAGE
#undef PG8_LDA
#undef PG8_LDB
#undef PG8_MMA
#undef PG8_WAIT_V
#undef PG8_WAIT_L
#undef PG8_BAR
#undef PG8_SCHED
}
}
using pg8::Unit;

struct EpiG1A {
    static constexpr bool PERM = true;
    bf16_t* UZ; bf16_t* VT; float* stat;
    DI void operator()(const f32x4 (&acc)[2][2][4][2], const Unit& u, int wr, int wc, int fr, int fq) const {
        if (u.pn < 16) {
#ifndef NO_UZ
            const int row0 = u.pm * 256 + wr * 64 + fr, col0 = u.pn * 128 + wc * 32 + 8 * fq;
#pragma unroll
            for (int ai = 0; ai < 2; ++ai)
#pragma unroll
                for (int m = 0; m < 4; ++m) {
                    const f32x4 u0 = acc[ai][0][m][0], u1 = acc[ai][0][m][1], z0 = acc[ai][1][m][0], z1 = acc[ai][1][m][1];
                    const f32x2 oa = gelu_silu_pk((f32x2){u0[0], u0[1]}, (f32x2){z0[0], z0[1]}), ob = gelu_silu_pk((f32x2){u0[2], u0[3]}, (f32x2){z0[2], z0[3]});
                    const f32x2 oc = gelu_silu_pk((f32x2){u1[0], u1[1]}, (f32x2){z1[0], z1[1]}), od = gelu_silu_pk((f32x2){u1[2], u1[3]}, (f32x2){z1[2], z1[3]});
                    u32x4 w; w.x = cvtpk(oa.x, oa.y); w.y = cvtpk(ob.x, ob.y); w.z = cvtpk(oc.x, oc.y); w.w = cvtpk(od.x, od.y);
                    *(u32x4*)(UZ + (size_t)(row0 + ai * 128 + m * 16) * AW + col0) = w;
                }
#endif
        } else {
#ifndef NO_VT
            const int ct = u.pn - 16;
            const int ch0 = ct * 256 + wr * 64 + fr, tok0 = u.pm * 256 + wc * 32 + 8 * fq;
            float one = 1.0f; asm volatile("" : "+v"(one));
#pragma unroll
            for (int bj = 0; bj < 2; ++bj) {
                float s1[8], s2[8];
#pragma unroll
                for (int t = 0; t < 8; ++t) { s1[t] = 0.f; s2[t] = 0.f; }
#pragma unroll
                for (int ai = 0; ai < 2; ++ai)
#pragma unroll
                    for (int m = 0; m < 4; ++m) {
                        float g[8];
#pragma unroll
                        for (int j = 0; j < 4; ++j) { g[j] = gelu_t(acc[ai][bj][m][0][j] * one); g[4 + j] = gelu_t(acc[ai][bj][m][1][j] * one); }
#pragma unroll
                        for (int j = 0; j < 8; ++j) { s1[j] += g[j]; s2[j] += g[j] * g[j]; }
                        u32x4 w; w.x = cvtpk(g[0], g[1]); w.y = cvtpk(g[2], g[3]); w.z = cvtpk(g[4], g[5]); w.w = cvtpk(g[6], g[7]);
                        *(u32x4*)(VT + (size_t)(ch0 + ai * 128 + m * 16) * T + tok0 + bj * 128) = w;
                    }
#pragma unroll
                for (int k = 0; k < 8; ++k) {
                    s1[k] = dpp_add<0xB1>(s1[k]); s2[k] = dpp_add<0xB1>(s2[k]);
                    s1[k] = dpp_add<0x4E>(s1[k]); s2[k] = dpp_add<0x4E>(s2[k]);
                    s1[k] = dpp_add<0x141>(s1[k]); s2[k] = dpp_add<0x141>(s2[k]);
                    s1[k] = dpp_add<0x140>(s1[k]); s2[k] = dpp_add<0x140>(s2[k]); }
#pragma unroll
                for (int k = 1; k < 8; ++k) { s1[0] = (fr == k) ? s1[k] : s1[0]; s2[0] = (fr == k) ? s2[k] : s2[0]; }
                if (fr < 8) { const int tok = tok0 + bj * 128 + fr;
                    *(f32x2*)(stat + ((size_t)tok * 16 + ct * 2 + wr) * 2) = (f32x2){s1[0], s2[0]}; }
            }
#endif
        }
    }
};

struct EpiG1B {
    static constexpr bool PERM = true;
    bf16_t* Q; bf16_t* Kb; bf16_t* Z; bf16_t* VT; const LAS float* rope;
    DI void operator()(const f32x4 (&acc)[2][2][4][2], const Unit& u, int wr, int wc, int fr, int fq) const {
        if (u.pn <= 4) {
            const bool isq = u.pn < 4, latent = u.pm < 64;
            const float sc = isq ? 0.125f * LOG2E : 1.0f;
            const int axis = wc & 1, f0 = 8 * (fq & 1);
            const float sgn = (fq < 2) ? -1.f : 1.f;
            bf16_t* base = isq ? Q + u.pn * 256 : Kb; const int ld = isq ? 1024 : 256;
#pragma unroll
            for (int ai = 0; ai < 2; ++ai)
#pragma unroll
                for (int m = 0; m < 4; ++m) {
                    const int row = u.pm * 256 + ai * 128 + wr * 64 + m * 16 + fr;
                    const int t = row & 4095, pos = axis ? (t & 63) : (t >> 6);
                    f32x4 c0 = {1.f, 1.f, 1.f, 1.f}, c1 = c0, s0 = {0.f, 0.f, 0.f, 0.f}, s1 = s0;
                    if (latent) { const LAS float* cp = rope + pos * 16 + f0; c0 = *(const LAS f32x4*)cp; c1 = *(const LAS f32x4*)(cp + 4); s0 = *(const LAS f32x4*)(cp + 1024); s1 = *(const LAS f32x4*)(cp + 1028); }
#pragma unroll
                    for (int bj = 0; bj < 2; ++bj) {
                        const f32x4 v0 = acc[ai][bj][m][0], v1 = acc[ai][bj][m][1];
                        float o[8];
#pragma unroll
                        for (int j = 0; j < 4; ++j) {
                            const float p0 = __shfl_xor(v0[j], 32), p1 = __shfl_xor(v1[j], 32);
                            o[j] = (v0[j] * c0[j] + sgn * p0 * s0[j]) * sc; o[4 + j] = (v1[j] * c1[j] + sgn * p1 * s1[j]) * sc; }
                        u32x4 w; w.x = cvtpk(o[0], o[1]); w.y = cvtpk(o[2], o[3]); w.z = cvtpk(o[4], o[5]); w.w = cvtpk(o[6], o[7]);
                        *(u32x4*)(base + (size_t)row * ld + bj * 128 + wc * 32 + 8 * fq) = w;
                    }
                }
        } else if (u.pn < 9) {
            bf16_t* base = Z + (u.pn - 5) * 256 + wc * 32 + 8 * fq;
#pragma unroll
            for (int ai = 0; ai < 2; ++ai)
#pragma unroll
                for (int m = 0; m < 4; ++m) {
                    const int row = u.pm * 256 + ai * 128 + wr * 64 + m * 16 + fr;
#pragma unroll
                    for (int bj = 0; bj < 2; ++bj) {
                        const f32x4 v0 = acc[ai][bj][m][0], v1 = acc[ai][bj][m][1];
                        const f32x2 sa = silu_pk2((f32x2){v0[0], v0[1]}), sb = silu_pk2((f32x2){v0[2], v0[3]}), sc2 = silu_pk2((f32x2){v1[0], v1[1]}), sd = silu_pk2((f32x2){v1[2], v1[3]});
                        u32x4 w; w.x = cvtpk(sa.x, sa.y); w.y = cvtpk(sb.x, sb.y); w.z = cvtpk(sc2.x, sc2.y); w.w = cvtpk(sd.x, sd.y);
                        *(u32x4*)(base + (size_t)row * 1024 + bj * 128) = w;
                    }
                }
        } else {
            const int tok0 = u.pm * 256 + wc * 32 + 8 * fq;
#pragma unroll
            for (int ai = 0; ai < 2; ++ai)
#pragma unroll
                for (int m = 0; m < 4; ++m) {
                    const int ch = ai * 128 + wr * 64 + m * 16 + fr;
#pragma unroll
                    for (int bj = 0; bj < 2; ++bj) {
                        const f32x4 v0 = acc[ai][bj][m][0], v1 = acc[ai][bj][m][1];
                        u32x4 w; w.x = cvtpk(v0[0], v0[1]); w.y = cvtpk(v0[2], v0[3]); w.z = cvtpk(v1[0], v1[1]); w.w = cvtpk(v1[2], v1[3]);
                        *(u32x4*)(VT + (size_t)ch * T + tok0 + bj * 128) = w;
                    }
                }
        }
    }
};

struct EpiG2 {
    static constexpr bool PERM = true;
    const float* x0; const unsigned short* rsrc; unsigned short* rdst;
    const float* xc0; unsigned short* rc;
    const float* gate; const float* rstat; const float* png; const float* pnb;
    DI void operator()(const f32x4 (&acc)[2][2][4][2], const Unit& u, int wr, int wc, int fr, int fq) const {
        const bool norm = x0 == nullptr;
        const int cb = u.pn * 256 + wc * 32 + 8 * fq;
        const float* gp = gate + (u.pm >> 4) * 3072 + cb;
        const int rbase = u.pm * 256 + wr * 64 + fr;
        const float* sp = rstat + (size_t)rbase * 2;
#pragma unroll
        for (int bj = 0; bj < 2; ++bj) {
            const int co = bj * 128;
            const f32x4 g0 = *(const f32x4*)(gp + co), g1 = *(const f32x4*)(gp + co + 4);
            f32x4 ng0 = {1.f, 1.f, 1.f, 1.f}, ng1 = ng0, nb0 = {0.f, 0.f, 0.f, 0.f}, nb1 = nb0;
            if (norm) { ng0 = *(const f32x4*)(png + cb + co); ng1 = *(const f32x4*)(png + cb + co + 4); nb0 = *(const f32x4*)(pnb + cb + co); nb1 = *(const f32x4*)(pnb + cb + co + 4); }
#pragma unroll
            for (int ai = 0; ai < 2; ++ai) {
                f32x4 xa[4], xb[4];
                if (norm) { u32x4 rv[4]; f32x2 st[4];
#pragma unroll
                    for (int m = 0; m < 4; ++m) { const int ro = ai * 128 + m * 16; rv[m] = *(const u32x4*)(rsrc + (size_t)(rbase + ro) * DM + cb + co); st[m] = *(const f32x2*)(sp + ro * 2); }
#pragma unroll
                    for (int m = 0; m < 4; ++m) { xa[m] = (f32x4){hlo(rv[m].x), hhi(rv[m].x), hlo(rv[m].y), hhi(rv[m].y)}; xb[m] = (f32x4){hlo(rv[m].z), hhi(rv[m].z), hlo(rv[m].w), hhi(rv[m].w)};
                        xa[m] = (xa[m] - st[m].x) * st[m].y * ng0 + nb0; xb[m] = (xb[m] - st[m].x) * st[m].y * ng1 + nb1; } }
                else {
#pragma unroll
                    for (int m = 0; m < 4; ++m) { const size_t off = (size_t)(rbase + ai * 128 + m * 16) * DM + cb + co;
                        xa[m] = __builtin_nontemporal_load((const f32x4*)(x0 + off)); xb[m] = __builtin_nontemporal_load((const f32x4*)(x0 + off + 4)); } }
#pragma unroll
                for (int m = 0; m < 4; ++m) { const size_t off = (size_t)(rbase + ai * 128 + m * 16) * DM + cb + co;
                    const f32x4 ra = xa[m] * ALPHA + g0 * acc[ai][bj][m][0], rb = xb[m] * ALPHA + g1 * acc[ai][bj][m][1];
                    u32x4 w; w.x = pkh(ra[0], ra[1]); w.y = pkh(ra[2], ra[3]); w.z = pkh(rb[0], rb[1]); w.w = pkh(rb[2], rb[3]);
                    *(u32x4*)(rdst + off) = w; }
            }
        }
    }
};

struct Params {
    const float* x; const float* c; const float* ctx; const float* c_ctx; const float* ada_w; const float* ada_b; const float* ln_g; const float* ln_b;
    const float* a_w_in; const float* a_ln_g; const float* a_ln_b; const float* a_w_s; const float* a_b_s; const float* a_w_out;
    const float* b_w_in; const float* b_sink; const float* b_w_out;
    float* out; unsigned char* ws;
};


DI void g2_ctx_small(const Params& P, LAS unsigned char* lds, const bf16_t* A  , const bf16_t* Bt, const int K, const EpiG2& E) {
    const int tid = opaque_tid(), lane = tid & 63, wave = __builtin_amdgcn_readfirstlane(tid >> 6);
    const int r16 = lane & 15, kq = lane >> 4;
    const int kw = K >> 3;
    LAS float* part = (LAS float*)lds;
    for (int tile = blockIdx.x; tile < 256; tile += gridDim.x) {
        const int tm = tile >> 4, tn = tile & 15;
        const bf16_t* ap = A + (size_t)(64 * tm + r16) * K + wave * kw + 8 * kq;
        const bf16_t* bp = Bt + (size_t)(64 * tn + r16) * K + wave * kw + 8 * kq;
        f32x4 acc[4][4];
#pragma unroll
        for (int i = 0; i < 4; ++i)
#pragma unroll
            for (int jj = 0; jj < 4; ++jj) acc[i][jj] = (f32x4){0.f, 0.f, 0.f, 0.f};
        bf16x8 a[2][4], b[2][4];
#pragma unroll
        for (int i = 0; i < 4; ++i) { a[0][i] = *(const bf16x8*)(ap + (size_t)(16 * i) * K); b[0][i] = *(const bf16x8*)(bp + (size_t)(16 * i) * K); }
#pragma unroll 1
        for (int k0 = 0; k0 < kw; k0 += 64) {
#pragma unroll
            for (int i = 0; i < 4; ++i) { a[1][i] = *(const bf16x8*)(ap + (size_t)(16 * i) * K + k0 + 32); b[1][i] = *(const bf16x8*)(bp + (size_t)(16 * i) * K + k0 + 32); }
#pragma unroll
            for (int i = 0; i < 4; ++i)
#pragma unroll
                for (int jj = 0; jj < 4; ++jj) acc[i][jj] = __builtin_amdgcn_mfma_f32_16x16x32_bf16(a[0][i], b[0][jj], acc[i][jj], 0, 0, 0);
            const int kn = (k0 + 64 < kw) ? (k0 + 64) : (kw - 32);
#pragma unroll
            for (int i = 0; i < 4; ++i) { a[0][i] = *(const bf16x8*)(ap + (size_t)(16 * i) * K + kn); b[0][i] = *(const bf16x8*)(bp + (size_t)(16 * i) * K + kn); }
#pragma unroll
            for (int i = 0; i < 4; ++i)
#pragma unroll
                for (int jj = 0; jj < 4; ++jj) acc[i][jj] = __builtin_amdgcn_mfma_f32_16x16x32_bf16(a[1][i], b[1][jj], acc[i][jj], 0, 0, 0);
        }
        __syncthreads();
#pragma unroll
        for (int i = 0; i < 4; ++i)
#pragma unroll
            for (int jj = 0; jj < 4; ++jj)
#pragma unroll
                for (int q = 0; q < 4; ++q) part[wave * 4096 + (16 * i + 4 * kq + q) * 64 + 16 * jj + r16] = acc[i][jj][q];
        __syncthreads();
        { const int row = tid >> 3, c0 = (tid & 7) * 8;
          f32x4 s0 = {0.f, 0.f, 0.f, 0.f}, s1 = s0;
#pragma unroll
          for (int w = 0; w < 8; ++w) { s0 += *(const LAS f32x4*)(part + w * 4096 + row * 64 + c0); s1 += *(const LAS f32x4*)(part + w * 4096 + row * 64 + c0 + 4); }
          const int crow = 64 * tm + row, col = 64 * tn + c0;
          const float* gp = E.gate + 4 * 3072 + col;
          const size_t off = (size_t)crow * DM + col;
          f32x4 x0, x1;
          if (E.xc0 != nullptr) { x0 = *(const f32x4*)(E.xc0 + off); x1 = *(const f32x4*)(E.xc0 + off + 4); }
          else { const u32x4 rv = *(const u32x4*)(E.rc + off); const f32x2 st = *(const f32x2*)(E.rstat + (size_t)(TL + crow) * 2);
              x0 = (f32x4){hlo(rv.x), hhi(rv.x), hlo(rv.y), hhi(rv.y)}; x1 = (f32x4){hlo(rv.z), hhi(rv.z), hlo(rv.w), hhi(rv.w)};
              x0 = (x0 - st.x) * st.y * *(const f32x4*)(E.png + col) + *(const f32x4*)(E.pnb + col);
              x1 = (x1 - st.x) * st.y * *(const f32x4*)(E.png + col + 4) + *(const f32x4*)(E.pnb + col + 4); }
          const f32x4 ra = x0 * ALPHA + *(const f32x4*)gp * s0, rb = x1 * ALPHA + *(const f32x4*)(gp + 4) * s1;
          u32x4 w; w.x = pkh(ra[0], ra[1]); w.y = pkh(ra[2], ra[3]); w.z = pkh(rb[0], rb[1]); w.w = pkh(rb[2], rb[3]);
          *(u32x4*)(E.rc + off) = w; }
    }
    __syncthreads();
}

DI void transpose_item(const float* W, int N, int K, bf16_t* WTrow  , int k0, int n0, LAS float* scr, int lane) {
    f32x4 tv[8];
#pragma unroll
    for (int i = 0; i < 8; ++i) tv[i] = __builtin_nontemporal_load((const f32x4*)(W + (size_t)(k0 + 8 * i + (lane >> 3)) * N + n0 + 4 * (lane & 7)));
#pragma unroll
    for (int i = 0; i < 8; ++i) { LAS float* d = scr + (8 * i + (lane >> 3)) * 33 + 4 * (lane & 7); d[0] = tv[i][0]; d[1] = tv[i][1]; d[2] = tv[i][2]; d[3] = tv[i][3]; }
    asm volatile("s_waitcnt lgkmcnt(0)" ::: "memory");
    const int c = lane & 7;
#pragma unroll
    for (int j = 0; j < 4; ++j) { const int n = (lane >> 3) + 8 * j; const LAS float* s = scr + (8 * c) * 33 + n;
        u32x4 o; o.x = cvtpk(s[0 * 33], s[1 * 33]); o.y = cvtpk(s[2 * 33], s[3 * 33]); o.z = cvtpk(s[4 * 33], s[5 * 33]); o.w = cvtpk(s[6 * 33], s[7 * 33]);
        *(u32x4*)(WTrow + (size_t)n * K + k0 + 8 * c) = o; }
    asm volatile("s_waitcnt lgkmcnt(0)" ::: "memory");
}

DI void p0_prologue(const Params& P, LAS unsigned char* lds) {
    const int tid = opaque_tid(), lane = tid & 63, wave = __builtin_amdgcn_readfirstlane(tid >> 6);
    unsigned char* ws = P.ws;
    {
        LAS float* scond = (LAS float*)lds;
        LAS float* red = (LAS float*)(lds + 32768);
        for (int idx = tid; idx < 5 * 1024; idx += NTHREADS) { const int r = idx >> 10, k = idx & 1023; const float v = r < 4 ? P.c[r * 1024 + k] : P.c_ctx[k]; scond[idx] = silu_f(v); }
        __syncthreads();
        for (int item = blockIdx.x; item < 192; item += gridDim.x) {
            const int li = item / 48, cc = item % 48, n = cc * 64 + lane;
            const float* wp = P.ada_w + (size_t)li * 1024 * 3072 + (size_t)(wave * 128) * 3072 + n;
            float a0 = 0.f, a1 = 0.f, a2 = 0.f, a3 = 0.f, a4 = 0.f;
#pragma unroll 1
            for (int kb = 0; kb < 128; kb += 32) {
                float wv[32];
#pragma unroll
                for (int k = 0; k < 32; ++k) wv[k] = __builtin_nontemporal_load(wp + (size_t)(kb + k) * 3072);
#pragma unroll
                for (int k = 0; k < 32; ++k) { const float w = wv[k]; const int kk = wave * 128 + kb + k;
                    a0 += scond[kk] * w; a1 += scond[1024 + kk] * w; a2 += scond[2048 + kk] * w; a3 += scond[3072 + kk] * w; a4 += scond[4096 + kk] * w; } }
            red[(wave * 5 + 0) * 64 + lane] = a0; red[(wave * 5 + 1) * 64 + lane] = a1; red[(wave * 5 + 2) * 64 + lane] = a2; red[(wave * 5 + 3) * 64 + lane] = a3; red[(wave * 5 + 4) * 64 + lane] = a4;
            __syncthreads();
            if (tid < 320) { const int r = tid >> 6, l = tid & 63; float s = P.ada_b[li * 3072 + cc * 64 + l];
#pragma unroll
                for (int w = 0; w < 8; ++w) s += red[(w * 5 + r) * 64 + l];
                ((float*)(ws + WS_MOD))[(li * 5 + r) * 3072 + cc * 64 + l] = s; }
            __syncthreads();
        }
    }
    if (blockIdx.x == gridDim.x - 1) {
        float* rope = (float*)(ws + WS_ROPE);
        for (int idx = tid; idx < 1024; idx += NTHREADS) { const int pos = idx >> 4, f = idx & 15;
            const float inv = exp2f(-(float)f * (13.287712379549449f / 16.0f)); const float ang = (float)pos * inv;
            rope[idx] = __cosf(ang); rope[1024 + idx] = __sinf(ang); }
    }
    __syncthreads();
    {
        LAS float* scr = (LAS float*)(lds + wave * 16384);
        const int gw = blockIdx.x * NWAVES + wave, NGW = gridDim.x * NWAVES;
        constexpr int I_AIN = 16 * 192, I_AOUT = 32 * 32, I_BIN = 16 * 80, I_BOUT = 16 * 32, I_PER = I_AIN + I_AOUT + I_BIN + I_BOUT;
        for (int it = gw; it < 2 * I_PER; it += NGW) {
            const int j = it / I_PER; int r = it % I_PER;
            unsigned char* wa = ws + WS_WA0 + (size_t)j * WA_SIZE; unsigned char* wb = ws + WS_WB0 + (size_t)j * WB_SIZE;
            if (r < I_AIN) { const int kb = r / 192, nb = r % 192, n0 = nb * 32; bf16_t* dst;
                if (n0 < 2048) dst = (bf16_t*)(wa + WA_UZ) + (size_t)(256 * (n0 >> 7) + (n0 & 127)) * 1024;
                else if (n0 < 4096) dst = (bf16_t*)(wa + WA_V) + (size_t)(n0 - 2048) * 1024;
                else { const int n1 = n0 - 4096; dst = (bf16_t*)(wa + WA_UZ) + (size_t)(256 * (n1 >> 7) + 128 + (n1 & 127)) * 1024; }
                transpose_item(P.a_w_in + (size_t)j * 1024 * 6144, 6144, 1024, dst, kb * 64, n0, scr, lane); continue; }
            r -= I_AIN;
            if (r < I_AOUT) { const int kb = r / 32, nb = r % 32, n0 = nb * 32;
                transpose_item(P.a_w_out + (size_t)j * 2048 * 1024, 1024, 2048, (bf16_t*)(wa + WA_OUT) + (size_t)n0 * 2048, kb * 64, n0, scr, lane); continue; }
            r -= I_AOUT;
            if (r < I_BIN) { const int kb = r / 80, nb = r % 80, n0 = nb * 32; bf16_t* dst;
                if (n0 < 1280) dst = (bf16_t*)(wb + WB_QKZ) + (size_t)n0 * 1024;
                else if (n0 < 1536) dst = (bf16_t*)(wb + WB_V) + (size_t)(n0 - 1280) * 1024;
                else dst = (bf16_t*)(wb + WB_QKZ) + (size_t)(n0 - 256) * 1024;
                transpose_item(P.b_w_in + (size_t)j * 1024 * 2560, 2560, 1024, dst, kb * 64, n0, scr, lane); continue; }
            r -= I_BIN;
            { const int kb = r / 32, nb = r % 32, n0 = nb * 32;
                transpose_item(P.b_w_out + (size_t)j * 1024 * 1024, 1024, 1024, (bf16_t*)(wb + WB_OUT) + (size_t)n0 * 1024, kb * 64, n0, scr, lane); }
        }
        const int gt = blockIdx.x * NTHREADS + tid, NGT = gridDim.x * NTHREADS;
        for (int i = gt; i < 2 * 8 * 128 * 128 / 8; i += NGT) { const int j = i >> 14, e = (i & 16383) * 8;
            const f32x4 v0 = *(const f32x4*)(P.a_w_s + (size_t)j * 131072 + e), v1 = *(const f32x4*)(P.a_w_s + (size_t)j * 131072 + e + 4);
            u32x4 w; w.x = cvtpk(v0[0], v0[1]); w.y = cvtpk(v0[2], v0[3]); w.z = cvtpk(v1[0], v1[1]); w.w = cvtpk(v1[2], v1[3]);
            *(u32x4*)((bf16_t*)(ws + WS_WA0 + (size_t)j * WA_SIZE + WA_S) + e) = w; }
    }
}

DI void p0b_h0(const Params& P) {
    const int tid = opaque_tid(), lane = tid & 63, wave = __builtin_amdgcn_readfirstlane(tid >> 6);
    const int gw = blockIdx.x * NWAVES + wave, NGW = gridDim.x * NWAVES;
    const float* mod = (const float*)(P.ws + WS_MOD);
    bf16_t* H = (bf16_t*)(P.ws + WS_H);
    for (int row = 2 * gw; row < T; row += 2 * NGW) {
        const float* xr = row < TL ? P.x + (size_t)row * DM : P.ctx + (size_t)(row - TL) * DM;
        const float* mr = mod + (row < TL ? (row >> 12) : 4) * 3072;
        f32x4 v[2][4], sh[4], sc[4];
#pragma unroll
        for (int q = 0; q < 2; ++q)
#pragma unroll
            for (int j = 0; j < 4; ++j) v[q][j] = __builtin_nontemporal_load((const f32x4*)(xr + q * DM + 4 * lane + 256 * j));
#pragma unroll
        for (int j = 0; j < 4; ++j) { const int c = 4 * lane + 256 * j; sh[j] = *(const f32x4*)(mr + c); sc[j] = *(const f32x4*)(mr + 1024 + c) + 1.0f; }
#pragma unroll
        for (int q = 0; q < 2; ++q)
#pragma unroll
            for (int j = 0; j < 4; ++j) { const int c = 4 * lane + 256 * j;
                const f32x4 h = v[q][j] * sc[j] + sh[j];
                u32x2 w; w.x = cvtpk(h[0], h[1]); w.y = cvtpk(h[2], h[3]);
                *(u32x2*)(H + (size_t)(row + q) * DM + c) = w; }
    }
}

DI void ln_phase(const Params& P, int layer) {
    const int tid = opaque_tid(), lane = tid & 63, wave = __builtin_amdgcn_readfirstlane(tid >> 6);
    const int gw = blockIdx.x * NWAVES + wave, NGW = gridDim.x * NWAVES;
    const bool last = layer == 3;
    const float* modn = (const float*)(P.ws + WS_MOD) + (layer + 1) * 15360;
    const float* lg = P.ln_g + layer * DM; const float* lb = P.ln_b + layer * DM;
    bf16_t* H = (bf16_t*)(P.ws + WS_H);
    const unsigned short* rl = last ? (const unsigned short*)(P.ws + WS_H) : (const unsigned short*)P.out;
    const unsigned short* rc = (const unsigned short*)(P.ws + WS_XC);
    float* rstat = (float*)(P.ws + WS_RSTAT);
    const int nrows = last ? TL : T;
    f32x4 g_[4], b_[4];
#pragma unroll
    for (int j = 0; j < 2; ++j) { const int c = 8 * lane + 512 * j; g_[2 * j] = *(const f32x4*)(lg + c); g_[2 * j + 1] = *(const f32x4*)(lg + c + 4); b_[2 * j] = *(const f32x4*)(lb + c); b_[2 * j + 1] = *(const f32x4*)(lb + c + 4); }
    for (int row = 2 * gw; row < nrows; row += 2 * NGW) {
        const unsigned short* xr = row < TL ? rl + (size_t)row * DM : rc + (size_t)(row - TL) * DM;
        const float* mr = modn + (row < TL ? (row >> 12) : 4) * 3072;
        u32x4 rv[2][2];
#pragma unroll
        for (int q = 0; q < 2; ++q)
#pragma unroll
            for (int j = 0; j < 2; ++j) rv[q][j] = *(const u32x4*)(xr + q * DM + 8 * lane + 512 * j);
        f32x4 G2_[4], B2_[4];
        if (!last) {
#pragma unroll
            for (int j = 0; j < 2; ++j) { const int c = 8 * lane + 512 * j;
                const f32x4 sca = *(const f32x4*)(mr + 1024 + c) + 1.0f, scb = *(const f32x4*)(mr + 1024 + c + 4) + 1.0f, sha = *(const f32x4*)(mr + c), shb = *(const f32x4*)(mr + c + 4);
                G2_[2 * j] = g_[2 * j] * sca; G2_[2 * j + 1] = g_[2 * j + 1] * scb; B2_[2 * j] = b_[2 * j] * sca + sha; B2_[2 * j + 1] = b_[2 * j + 1] * scb + shb; }
        } else {
#pragma unroll
            for (int i = 0; i < 4; ++i) { G2_[i] = g_[i]; B2_[i] = b_[i]; }
        }
        f32x4 v[2][4]; float s[2] = {0.f, 0.f};
#pragma unroll
        for (int q = 0; q < 2; ++q)
#pragma unroll
            for (int j = 0; j < 2; ++j) { const u32x4 t = rv[q][j];
                v[q][2 * j] = (f32x4){hlo(t.x), hhi(t.x), hlo(t.y), hhi(t.y)}; v[q][2 * j + 1] = (f32x4){hlo(t.z), hhi(t.z), hlo(t.w), hhi(t.w)}; }
#pragma unroll
        for (int q = 0; q < 2; ++q)
#pragma unroll
            for (int j = 0; j < 4; ++j) s[q] += (v[q][j][0] + v[q][j][1]) + (v[q][j][2] + v[q][j][3]);
#pragma unroll
        for (int q = 0; q < 2; ++q) s[q] = wave_sum_dpp(s[q]);
        float mean[2], s2[2] = {0.f, 0.f};
#pragma unroll
        for (int q = 0; q < 2; ++q) { mean[q] = s[q] * (1.f / DM);
#pragma unroll
            for (int j = 0; j < 4; ++j) { v[q][j] = v[q][j] - mean[q]; s2[q] += (v[q][j][0] * v[q][j][0] + v[q][j][1] * v[q][j][1]) + (v[q][j][2] * v[q][j][2] + v[q][j][3] * v[q][j][3]); } }
#pragma unroll
        for (int q = 0; q < 2; ++q) s2[q] = wave_sum_dpp(s2[q]);
#pragma unroll
        for (int q = 0; q < 2; ++q) {
            const float rstd = 1.0f / sqrtf(s2[q] * (1.f / DM) + LN_EPS);
#pragma unroll
            for (int j = 0; j < 2; ++j) { const int c = 8 * lane + 512 * j;
                const f32x4 ya = v[q][2 * j] * rstd * G2_[2 * j] + B2_[2 * j], yb = v[q][2 * j + 1] * rstd * G2_[2 * j + 1] + B2_[2 * j + 1];
                if (last) { float* op = P.out + (size_t)(row + q) * DM + c; __builtin_nontemporal_store(ya, (f32x4*)op); __builtin_nontemporal_store(yb, (f32x4*)(op + 4)); }
                else { u32x4 w; w.x = cvtpk(ya[0], ya[1]); w.y = cvtpk(ya[2], ya[3]); w.z = cvtpk(yb[0], yb[1]); w.w = cvtpk(yb[2], yb[3]);
                    *(u32x4*)(H + (size_t)(row + q) * DM + c) = w; }
            }
            if (!last && lane == 0) *(f32x2*)(rstat + (size_t)(row + q) * 2) = (f32x2){mean[q], rstd};
        }
    }
}

DI void spatial_mix(const Params& P, int j, LAS unsigned char* lds) {
    const int tid = opaque_tid(), lane = tid & 63, wave = __builtin_amdgcn_readfirstlane(tid >> 6);
    const bf16_t* Wsb = (const bf16_t*)(P.ws + WS_WA0 + (size_t)j * WA_SIZE + WA_S);
    const float* bs = P.a_b_s + j * 1024; const float* lng = P.a_ln_g + j * AW; const float* lnb = P.a_ln_b + j * AW;
    const bf16_t* VT = (const bf16_t*)(P.ws + WS_ACT + ACT_VTA); bf16_t* UZ = (bf16_t*)(P.ws + WS_ACT + ACT_UZ);
    const float* stat = (const float*)(P.ws + WS_STAT);
    LAS unsigned char* Wl = lds;
    LAS float* smu = (LAS float*)(lds + 36864);
    const int r16 = lane & 15, kq = lane >> 4;
    const bool hoist = (gridDim.x & 7) == 0 && gridDim.x * 8 >= 136 * 8;
    if (hoist) {
        const int g = blockIdx.x & 7;
#pragma unroll
        for (int i = 0; i < 4; ++i) { const int piece = tid + NTHREADS * i, row = piece >> 4, cp = piece & 15;
            *(LAS u32x4*)(Wl + row * 272 + cp * 16) = *(const u32x4*)(Wsb + (size_t)g * 16384 + row * 128 + cp * 8); }
        for (int t = tid; t < 8 * 128; t += NTHREADS) { const int it = t >> 7, item = blockIdx.x + it * gridDim.x;
            if (item < 136 * 8) { const float* sp = stat + (size_t)((item >> 3) * 128 + (t & 127)) * 32; float a = 0.f, b = 0.f;
#pragma unroll
                for (int q8 = 0; q8 < 8; ++q8) { const f32x4 q = *(const f32x4*)(sp + 4 * q8); a += q[0] + q[2]; b += q[1] + q[3]; }
                const float mu = a * (1.f / AW); const float var = fmaxf(b * (1.f / AW) - mu * mu, 0.f);
                smu[it * 256 + (t & 127)] = mu; smu[it * 256 + 128 + (t & 127)] = 1.0f / sqrtf(var + LN_EPS); } }
        __syncthreads();
    }
    int itn = 0;
    for (int item = blockIdx.x; item < 136 * 8; item += gridDim.x, ++itn) {
        const int chunk = item >> 3, g = item & 7;
        if (!hoist) {
        __syncthreads();
        if (tid < 128) { const float* sp = stat + (size_t)(chunk * 128 + tid) * 32; float a = 0.f, b = 0.f;
#pragma unroll
            for (int s = 0; s < 8; ++s) { const f32x4 q = *(const f32x4*)(sp + 4 * s); a += q[0] + q[2]; b += q[1] + q[3]; }
            const float mu = a * (1.f / AW); const float var = fmaxf(b * (1.f / AW) - mu * mu, 0.f);
            smu[tid] = mu; smu[128 + tid] = 1.0f / sqrtf(var + LN_EPS); }
#pragma unroll
        for (int i = 0; i < 4; ++i) { const int piece = tid + NTHREADS * i, row = piece >> 4, cp = piece & 15;
            *(LAS u32x4*)(Wl + row * 272 + cp * 16) = *(const u32x4*)(Wsb + (size_t)g * 16384 + row * 128 + cp * 8); }
        __syncthreads();
        }
        const LAS float* smu_i = smu + (hoist ? itn * 256 : 0); const LAS float* srs_i = smu_i + 128;
        const int cw = g * 256 + 32 * wave;
        u32x4 gvr[2][4]; float ga[2], be[2];
#pragma unroll
        for (int ct = 0; ct < 2; ++ct) { const int ch = cw + 16 * ct + r16; ga[ct] = lng[ch]; be[ct] = lnb[ch];
#pragma unroll
            for (int ks = 0; ks < 4; ++ks) gvr[ct][ks] = *(const u32x4*)(VT + (size_t)ch * T + chunk * 128 + 32 * ks + 8 * kq); }
        u32x2 uzr[8][2];
        float bsr[8];
#pragma unroll
        for (int pt = 0; pt < 8; ++pt) bsr[pt] = bs[g * 128 + 16 * pt + r16];
        __builtin_amdgcn_sched_barrier(0);
#pragma unroll
        for (int pt = 0; pt < 8; ++pt)
#pragma unroll
            for (int ct = 0; ct < 2; ++ct) uzr[pt][ct] = *(const u32x2*)(UZ + (size_t)(chunk * 128 + 16 * pt + r16) * AW + cw + 16 * ct + 4 * kq);
        f32x4 acc[2][8];
#pragma unroll
        for (int ct = 0; ct < 2; ++ct)
#pragma unroll
            for (int pt = 0; pt < 8; ++pt) acc[ct][pt] = (f32x4){0.f, 0.f, 0.f, 0.f};
#pragma unroll
        for (int ks = 0; ks < 4; ++ks) {
            const f32x4 m0 = *(const LAS f32x4*)(smu_i + 32 * ks + 8 * kq), m1 = *(const LAS f32x4*)(smu_i + 32 * ks + 8 * kq + 4);
            const f32x4 r0 = *(const LAS f32x4*)(srs_i + 32 * ks + 8 * kq), r1 = *(const LAS f32x4*)(srs_i + 32 * ks + 8 * kq + 4);
            bf16x8 af[2];
#pragma unroll
            for (int ct = 0; ct < 2; ++ct) { const u32x4 gq = gvr[ct][ks];
                u32x4 w;
                w.x = cvtpk((bflo(gq.x) - m0[0]) * r0[0] * ga[ct] + be[ct], (bfhi(gq.x) - m0[1]) * r0[1] * ga[ct] + be[ct]);
                w.y = cvtpk((bflo(gq.y) - m0[2]) * r0[2] * ga[ct] + be[ct], (bfhi(gq.y) - m0[3]) * r0[3] * ga[ct] + be[ct]);
                w.z = cvtpk((bflo(gq.z) - m1[0]) * r1[0] * ga[ct] + be[ct], (bfhi(gq.z) - m1[1]) * r1[1] * ga[ct] + be[ct]);
                w.w = cvtpk((bflo(gq.w) - m1[2]) * r1[2] * ga[ct] + be[ct], (bfhi(gq.w) - m1[3]) * r1[3] * ga[ct] + be[ct]);
                af[ct] = __builtin_bit_cast(bf16x8, w); }
#pragma unroll
            for (int pt = 0; pt < 8; ++pt) { const bf16x8 bfr = *(const LAS bf16x8*)(Wl + (16 * pt + r16) * 272 + (32 * ks + 8 * kq) * 2);
                acc[0][pt] = __builtin_amdgcn_mfma_f32_16x16x32_bf16(af[0], bfr, acc[0][pt], 0, 0, 0);
                acc[1][pt] = __builtin_amdgcn_mfma_f32_16x16x32_bf16(af[1], bfr, acc[1][pt], 0, 0, 0); }
        }
#pragma unroll
        for (int pt = 0; pt < 8; ++pt) { const int p = 16 * pt + r16; const float bsv = bsr[pt];
#pragma unroll
            for (int ct = 0; ct < 2; ++ct) { bf16_t* up = UZ + (size_t)(chunk * 128 + p) * AW + cw + 16 * ct + 4 * kq;
                const u32x2 uz = uzr[pt][ct]; const f32x4 a = acc[ct][pt];
                u32x2 w; w.x = cvtpk(bflo(uz.x) * (a[0] + bsv), bfhi(uz.x) * (a[1] + bsv)); w.y = cvtpk(bflo(uz.y) * (a[2] + bsv), bfhi(uz.y) * (a[3] + bsv));
                *(u32x2*)up = w; } }
    }
}

DI void attn_phase(const Params& P, int j, bool ctxq, LAS unsigned char* lds) {
    const int tid = opaque_tid(), lane = tid & 63, wave = __builtin_amdgcn_readfirstlane(tid >> 6);
    const bf16_t* Q = (const bf16_t*)(P.ws + WS_ACT + ACT_Q); const bf16_t* Kb = (const bf16_t*)(P.ws + WS_ACT + ACT_K);
    const bf16_t* VT = (const bf16_t*)(P.ws + WS_ACT + ACT_VTB); const bf16_t* Z = (const bf16_t*)(P.ws + WS_ACT + ACT_Z); bf16_t* OZ = (bf16_t*)(P.ws + WS_ACT + ACT_OZ);
    const float* sink = P.b_sink + j * 16;
    const int r = lane & 31, h = lane >> 5;
    const int nitems = 1024 + (ctxq ? 64 : 0);
    const int g = wave >> 1, sub = wave & 1;
    constexpr int KP = 144, VP = 136, VOFF = 64 * KP, BUFB = VOFF + 64 * VP;
    const int lrow = tid >> 3, lpc = tid & 7;
    const int kw_off = lrow * KP + lpc * 16, vw_off = VOFF + lrow * VP + lpc * 16;
    const int kfo = r * KP + 16 * h, vfo = VOFF + r * VP + 8 * h;
    const int vcu = (gridDim.x % 8 == 0) ? (int)((blockIdx.x % 8) * (gridDim.x / 8) + blockIdx.x / 8) : (int)blockIdx.x;
    for (int bi = vcu; bi < nitems; bi += gridDim.x) {
        int b, kvh, qrow0, jt_lo, nband, bandrow0, ctxrow0;
        if (bi < 1024) { b = bi >> 8; kvh = (bi >> 6) & 3; const int q64 = bi & 63, qbase = 64 * q64; qrow0 = b * SEQ + qbase + 32 * sub;
            jt_lo = (4 - 2 * q64) > 0 ? (4 - 2 * q64) : 0; const int jt_hi = (131 - 2 * q64) < 9 ? (131 - 2 * q64) : 9; nband = jt_hi - jt_lo + 1; bandrow0 = b * SEQ + qbase - 128; }
        else { const int ci = bi - 1024; b = ci >> 4; kvh = (ci >> 2) & 3; qrow0 = TL + b * CL + 64 * (ci & 3) + 32 * sub; jt_lo = 0; nband = 0; bandrow0 = 0; }
        ctxrow0 = TL + b * CL;
        const int NT = nband + 8, NS = (NT + 1) >> 1;
        const int head = kvh * 4 + g;
        const bf16_t* ksrc = Kb + (size_t)(lrow & 31) * 256 + kvh * 64 + lpc * 8;
        const bf16_t* vsrc = VT + (size_t)(kvh * 64 + lrow) * T + (lpc & 3) * 8;
#define ATT_KROW(i) ((i) < nband ? (bandrow0 + 32 * (jt_lo + (i))) : (ctxrow0 + 32 * ((i) - nband)))
#define ATT_TIDX(st, w) ((2 * (st) + (w)) < NT ? (2 * (st) + (w)) : (NT - 1))
#define ATT_GLOADK(st) (*(const u32x4*)(ksrc + (size_t)ATT_KROW(ATT_TIDX(st, lrow >> 5)) * 256))
#define ATT_GLOADV(st) (*(const u32x4*)(vsrc + (size_t)ATT_KROW(ATT_TIDX(st, lpc >> 2))))
#define ATT_LWRITE(bufi, kv, vv) do { LAS unsigned char* _p = lds + (bufi) * BUFB; *(LAS u32x4*)(_p + kw_off) = (kv); \
            *(LAS u32x2*)(_p + vw_off) = (u32x2){(vv).x, (vv).y}; *(LAS u32x2*)(_p + vw_off + 8) = (u32x2){(vv).z, (vv).w}; } while (0)
        bf16x8 qf[4];
#pragma unroll
        for (int s = 0; s < 4; ++s) qf[s] = *(const bf16x8*)(Q + (size_t)(qrow0 + r) * 1024 + head * 64 + 16 * s + 8 * h);
        const size_t obase = (size_t)(qrow0 + r) * 1024 + head * 64 + 4 * h;
        u32x2 zr[2][4];
#pragma unroll
        for (int g4 = 0; g4 < 4; ++g4) { zr[0][g4] = *(const u32x2*)(Z + obase + 8 * g4); zr[1][g4] = *(const u32x2*)(Z + obase + 32 + 8 * g4); }
        float m_run = sink[head] * LOG2E; float l_part = (h == 0) ? 1.f : 0.f;
        f32x16 o0, o1;
#pragma unroll
        for (int i = 0; i < 16; ++i) { o0[i] = 0.f; o1[i] = 0.f; }
        __syncthreads();
        u32x4 rk[2], rv[2];
        rk[0] = ATT_GLOADK(0); rv[0] = ATT_GLOADV(0); rk[1] = ATT_GLOADK(1); rv[1] = ATT_GLOADV(1);
        ATT_LWRITE(0, rk[0], rv[0]);
        __syncthreads();
        for (int st0 = 0; st0 < NS; st0 += 2) {
#pragma unroll
            for (int u2 = 0; u2 < 2; ++u2) {
                const int st = st0 + u2;
                if (st < NS) {
                    rk[u2] = ATT_GLOADK(st + 2); rv[u2] = ATT_GLOADV(st + 2);
                    const LAS unsigned char* bp = lds + (st & 1) * BUFB;
                    int mode[2];
#pragma unroll
                    for (int w = 0; w < 2; ++w) { const int i = 2 * st + w; const int t = jt_lo + i - sub;
                        mode[w] = (i >= NT) ? 3 : ((i >= nband) ? 0 : ((t < 0 || t > 8) ? 3 : (t == 0 ? 1 : (t == 8 ? 2 : 0)))); }
                    const int mA = __builtin_amdgcn_readfirstlane(mode[0]), mB = __builtin_amdgcn_readfirstlane(mode[1]);
                    if ((mA | mB) != 0) {
                        asm volatile("" ::: "memory");
                    f32x16 S[2];
#pragma unroll
                        for (int w = 0; w < 2; ++w)
#pragma unroll
                            for (int q = 0; q < 16; ++q) S[w][q] = 0.f;
#pragma unroll
                        for (int s = 0; s < 4; ++s) {
                            const bf16x8 ka = *(const LAS bf16x8*)(bp + kfo + 32 * s), kb = *(const LAS bf16x8*)(bp + kfo + 32 * KP + 32 * s);
                            S[0] = __builtin_amdgcn_mfma_f32_32x32x16_bf16(ka, qf[s], S[0], 0, 0, 0); S[1] = __builtin_amdgcn_mfma_f32_32x32x16_bf16(kb, qf[s], S[1], 0, 0, 0); }
                        {
                        const int rr = r - 4 * h;
#pragma unroll
                        for (int w = 0; w < 2; ++w) { const int mw = w ? mB : mA;
                            if (mw == 1) {
#pragma unroll
                                for (int q = 0; q < 16; ++q) { const int c = (q & 3) + 8 * (q >> 2); S[w][q] = (c >= rr) ? S[w][q] : -1e30f; } }
                            else if (mw == 2) {
#pragma unroll
                                for (int q = 0; q < 16; ++q) { const int c = (q & 3) + 8 * (q >> 2); S[w][q] = (c <= rr) ? S[w][q] : -1e30f; } }
                            else if (mw == 3) {
#pragma unroll
                                for (int q = 0; q < 16; ++q) S[w][q] = -1e30f; } }
                        }
                    float mx = max3f(S[0][0], S[1][0], m_run);
#pragma unroll
                        for (int q = 1; q < 16; ++q) mx = max3f(mx, S[0][q], S[1][q]);
                        mx = fmaxf(mx, xhalf_f(mx));
                        if (__builtin_amdgcn_ballot_w64(mx - m_run > 8.0f) != 0ull) { const float alpha = __builtin_amdgcn_exp2f(m_run - mx); l_part *= alpha; m_run = mx;
#pragma unroll
                            for (int q = 0; q < 16; ++q) { o0[q] *= alpha; o1[q] *= alpha; } }
                        f32x2 ps2 = {0.f, 0.f}; const f32x2 mn2 = {m_run, m_run};
#pragma unroll
                        for (int w = 0; w < 2; ++w)
#pragma unroll
                            for (int q = 0; q < 16; q += 2) { const f32x2 d = (f32x2){S[w][q], S[w][q + 1]} - mn2;
                                const f32x2 e = {__builtin_amdgcn_exp2f(d.x), __builtin_amdgcn_exp2f(d.y)}; S[w][q] = e.x; S[w][q + 1] = e.y; ps2 += e; }
                        const float psum = ps2.x + ps2.y;
                        l_part += psum;
#pragma unroll
                        for (int w = 0; w < 2; ++w)
#pragma unroll
                            for (int s = 0; s < 2; ++s) { u32x4 pw; pw.x = cvtpk(S[w][8 * s], S[w][8 * s + 1]); pw.y = cvtpk(S[w][8 * s + 2], S[w][8 * s + 3]); pw.z = cvtpk(S[w][8 * s + 4], S[w][8 * s + 5]); pw.w = cvtpk(S[w][8 * s + 6], S[w][8 * s + 7]);
                                const bf16x8 pf = __builtin_bit_cast(bf16x8, pw);
                                const int vo = vfo + 64 * w + 32 * s;
                                const u32x2 a0 = *(const LAS u32x2*)(bp + vo), a1 = *(const LAS u32x2*)(bp + vo + 16);
                                const u32x2 c0 = *(const LAS u32x2*)(bp + vo + 32 * VP), c1 = *(const LAS u32x2*)(bp + vo + 32 * VP + 16);
                                const bf16x8 va = __builtin_bit_cast(bf16x8, (u32x4){a0.x, a0.y, a1.x, a1.y}), vb = __builtin_bit_cast(bf16x8, (u32x4){c0.x, c0.y, c1.x, c1.y});
                                o0 = __builtin_amdgcn_mfma_f32_32x32x16_bf16(va, pf, o0, 0, 0, 0); o1 = __builtin_amdgcn_mfma_f32_32x32x16_bf16(vb, pf, o1, 0, 0, 0); }
                    } else {
                    f32x16 S[2];
#pragma unroll
                        for (int w = 0; w < 2; ++w)
#pragma unroll
                            for (int q = 0; q < 16; ++q) S[w][q] = 0.f;
#pragma unroll
                        for (int s = 0; s < 4; ++s) {
                            const bf16x8 ka = *(const LAS bf16x8*)(bp + kfo + 32 * s), kb = *(const LAS bf16x8*)(bp + kfo + 32 * KP + 32 * s);
                            S[0] = __builtin_amdgcn_mfma_f32_32x32x16_bf16(ka, qf[s], S[0], 0, 0, 0); S[1] = __builtin_amdgcn_mfma_f32_32x32x16_bf16(kb, qf[s], S[1], 0, 0, 0); }
                    float mx = max3f(S[0][0], S[1][0], m_run);
#pragma unroll
                        for (int q = 1; q < 16; ++q) mx = max3f(mx, S[0][q], S[1][q]);
                        mx = fmaxf(mx, xhalf_f(mx));
                        if (__builtin_amdgcn_ballot_w64(mx - m_run > 8.0f) != 0ull) { const float alpha = __builtin_amdgcn_exp2f(m_run - mx); l_part *= alpha; m_run = mx;
#pragma unroll
                            for (int q = 0; q < 16; ++q) { o0[q] *= alpha; o1[q] *= alpha; } }
                        f32x2 ps2 = {0.f, 0.f}; const f32x2 mn2 = {m_run, m_run};
#pragma unroll
                        for (int w = 0; w < 2; ++w)
#pragma unroll
                            for (int q = 0; q < 16; q += 2) { const f32x2 d = (f32x2){S[w][q], S[w][q + 1]} - mn2;
                                const f32x2 e = {__builtin_amdgcn_exp2f(d.x), __builtin_amdgcn_exp2f(d.y)}; S[w][q] = e.x; S[w][q + 1] = e.y; ps2 += e; }
                        const float psum = ps2.x + ps2.y;
                        l_part += psum;
#pragma unroll
                        for (int w = 0; w < 2; ++w)
#pragma unroll
                            for (int s = 0; s < 2; ++s) { u32x4 pw; pw.x = cvtpk(S[w][8 * s], S[w][8 * s + 1]); pw.y = cvtpk(S[w][8 * s + 2], S[w][8 * s + 3]); pw.z = cvtpk(S[w][8 * s + 4], S[w][8 * s + 5]); pw.w = cvtpk(S[w][8 * s + 6], S[w][8 * s + 7]);
                                const bf16x8 pf = __builtin_bit_cast(bf16x8, pw);
                                const int vo = vfo + 64 * w + 32 * s;
                                const u32x2 a0 = *(const LAS u32x2*)(bp + vo), a1 = *(const LAS u32x2*)(bp + vo + 16);
                                const u32x2 c0 = *(const LAS u32x2*)(bp + vo + 32 * VP), c1 = *(const LAS u32x2*)(bp + vo + 32 * VP + 16);
                                const bf16x8 va = __builtin_bit_cast(bf16x8, (u32x4){a0.x, a0.y, a1.x, a1.y}), vb = __builtin_bit_cast(bf16x8, (u32x4){c0.x, c0.y, c1.x, c1.y});
                                o0 = __builtin_amdgcn_mfma_f32_32x32x16_bf16(va, pf, o0, 0, 0, 0); o1 = __builtin_amdgcn_mfma_f32_32x32x16_bf16(vb, pf, o1, 0, 0, 0); }
                    }
                    ATT_LWRITE((st + 1) & 1, rk[u2 ^ 1], rv[u2 ^ 1]);
                    __syncthreads();
                }
            }
        }
#undef ATT_KROW
#undef ATT_TIDX
#undef ATT_GLOADK
#undef ATT_GLOADV
#undef ATT_LWRITE
        const float l = l_part + __shfl_xor(l_part, 32); const float inv = 1.0f / l;
#pragma unroll
        for (int g4 = 0; g4 < 4; ++g4) {
            { const u32x2 z = zr[0][g4]; u32x2 w;
              w.x = cvtpk(o0[4 * g4] * inv * bflo(z.x), o0[4 * g4 + 1] * inv * bfhi(z.x)); w.y = cvtpk(o0[4 * g4 + 2] * inv * bflo(z.y), o0[4 * g4 + 3] * inv * bfhi(z.y));
              *(u32x2*)(OZ + obase + 8 * g4) = w; }
            { const u32x2 z = zr[1][g4]; u32x2 w;
              w.x = cvtpk(o1[4 * g4] * inv * bflo(z.x), o1[4 * g4 + 1] * inv * bfhi(z.x)); w.y = cvtpk(o1[4 * g4 + 2] * inv * bflo(z.y), o1[4 * g4 + 3] * inv * bfhi(z.y));
              *(u32x2*)(OZ + obase + 32 + 8 * g4) = w; }
        }
    }
}

#define XB_TMO      128
#define XB_XCNT(j)  (256  + 64 * (j))
#define XB_XSUB(j)  (1280 + 64 * (j))
#define XB_XGEN(j)  (2304 + 64 * (j))
#define XB_TOP      3328
#define XB_TOPGEN   3392
#define XCD_BAR_WORDS 3456
#define XB_SPIN_CAP (1u << 18)
DI unsigned xb_ld(unsigned* p)              { return __hip_atomic_load(p, __ATOMIC_RELAXED, __HIP_MEMORY_SCOPE_AGENT); }
DI unsigned xb_add(unsigned* p, unsigned v) { return __hip_atomic_fetch_add(p, v, __ATOMIC_RELAXED, __HIP_MEMORY_SCOPE_AGENT); }
DI unsigned xb_xcc_id() { return (unsigned)__builtin_amdgcn_s_getreg((3 << 11) | 20) & 0xFu; }
#define XB_SPIN(cond, bar) do { unsigned _sp = 0; while (cond) { __builtin_amdgcn_s_sleep(1); \
    if ((++_sp & 255u) == 0u) { if (xb_ld(&(bar)[XB_TMO])) break; if (_sp > XB_SPIN_CAP) { atomicAdd(&(bar)[XB_TMO], 1u); break; } } } } while (0)
struct XcdBarrier { unsigned* bar; unsigned x; volatile LAS unsigned* st; };
DI XcdBarrier xcd_barrier_post(unsigned* bar, volatile LAS unsigned* st) {
    XcdBarrier b; b.bar = bar; b.x = xb_xcc_id(); b.st = st;
    if (threadIdx.x == 0) (void)xb_add(&bar[XB_XCNT(b.x)], 1u);
    return b;
}
DI void xcd_barrier_census_wave(unsigned* bar, unsigned x, volatile LAS unsigned* st) {
    const unsigned G = gridDim.x * gridDim.y * gridDim.z;
    const unsigned lane = threadIdx.x & 63u;
    unsigned c, sum, sp = 0u;
    for (;;) {
        c = lane < 16u ? xb_ld(&bar[XB_XCNT(lane)]) : 0u;
        sum = c;
#pragma unroll
        for (int o = 1; o < 64; o <<= 1) sum += (unsigned)__shfl_xor((int)sum, o);
        if (sum == G) break;
        __builtin_amdgcn_s_sleep(1);
        if ((++sp & 255u) == 0u) { if (xb_ld(&bar[XB_TMO])) break; if (sp > XB_SPIN_CAP) { if (lane == 0u) atomicAdd(&bar[XB_TMO], 1u); break; } }
    }
    const unsigned cnt = (unsigned)__popcll(__builtin_amdgcn_ballot_w64(c > 0u));
    const unsigned mine = (unsigned)__shfl((int)c, (int)x);
    if (lane == 0u) { st[0] = mine > 0u ? mine : 1u; st[1] = cnt > 0u ? cnt : 1u; }
}
DI void xcd_barrier(const XcdBarrier& b) {
    asm volatile("s_waitcnt vmcnt(0)" ::: "memory");
    __syncthreads();
    if (threadIdx.x == 0) {
        unsigned* bar = b.bar;
        __builtin_amdgcn_s_waitcnt(0);
        const unsigned nloc = b.st[0], nx = b.st[1];
        const unsigned old = xb_add(&bar[XB_XSUB(b.x)], 1u);
        const unsigned gen = old / nloc;
        if (old + 1u == (gen + 1u) * nloc) {
            __builtin_amdgcn_fence(__ATOMIC_RELEASE, "agent");
            asm volatile("s_waitcnt vmcnt(0)" ::: "memory");
            const unsigned og = xb_add(&bar[XB_TOP], 1u);
            const unsigned tg = og / nx;
            if (og + 1u == (tg + 1u) * nx) xb_add(&bar[XB_TOPGEN], 1u);
            else XB_SPIN(xb_ld(&bar[XB_TOPGEN]) == tg, bar);
            __builtin_amdgcn_fence(__ATOMIC_ACQUIRE, "agent");
            xb_add(&bar[XB_XGEN(b.x)], 1u);
            asm volatile("s_waitcnt vmcnt(0)" ::: "memory");
        } else {
            XB_SPIN(xb_ld(&bar[XB_XGEN(b.x)]) == gen, bar);
            __builtin_amdgcn_fence(__ATOMIC_ACQUIRE, "agent");
            asm volatile("s_waitcnt vmcnt(0)" ::: "memory");
        }
    }
    __syncthreads();
}

__global__ void __launch_bounds__(NTHREADS, 2) fwd_megakernel(Params P) {
    extern __shared__ __attribute__((aligned(16))) unsigned char lds_raw[];
    LAS unsigned char* lds = (LAS unsigned char*)lds_raw;
    { volatile LAS unsigned* st0 = (volatile LAS unsigned*)(lds + 143360); if (threadIdx.x < 2) st0[threadIdx.x] = 0u; }
    __syncthreads();
    cg::this_grid().sync();
    (void)xcd_barrier_post((unsigned*)(P.ws + WS_BAR), (volatile LAS unsigned*)(lds + 143360));
#define GSYNC() do { XcdBarrier xb_; xb_.bar = (unsigned*)(P.ws + WS_BAR); xb_.x = xb_xcc_id(); xb_.st = (volatile LAS unsigned*)(lds + 143360); xcd_barrier(xb_); } while (0)
    unsigned char* ws = P.ws;
    const int G = gridDim.x, cid = blockIdx.x;

#ifndef SKIP_P0
    p0_prologue(P, lds);
#endif
    if (threadIdx.x < 64) xcd_barrier_census_wave((unsigned*)(P.ws + WS_BAR), xb_xcc_id(), (volatile LAS unsigned*)(lds + 143360));
    GSYNC();
#ifndef SKIP_P0B
    p0b_h0(P);
#endif
    GSYNC();

    const bf16_t* H = (const bf16_t*)(ws + WS_H);
    const float* mod = (const float*)(ws + WS_MOD);
#pragma nounroll
    for (int layer = 0; layer < 4; ++layer) {
        const int j = layer >> 1;
        EpiG2 E2; E2.x0 = layer == 0 ? P.x : nullptr; E2.rsrc = (const unsigned short*)P.out; E2.rdst = layer == 3 ? (unsigned short*)(ws + WS_H) : (unsigned short*)P.out;
        E2.xc0 = layer == 0 ? P.ctx : nullptr; E2.rc = (unsigned short*)(ws + WS_XC); E2.gate = mod + layer * 15360 + 2048;
        E2.rstat = (const float*)(ws + WS_RSTAT); E2.png = P.ln_g + (layer > 0 ? layer - 1 : 0) * DM; E2.pnb = P.ln_b + (layer > 0 ? layer - 1 : 0) * DM;
        const int nM2 = 64;
        if ((layer & 1) == 0) {
            unsigned char* wa = ws + WS_WA0 + (size_t)j * WA_SIZE;
            { pg8::VSched S; S.init(68, 24, 16, G, cid, H, wa + WA_UZ, wa + WA_V, 1024);
              EpiG1A E; E.UZ = (bf16_t*)(ws + WS_ACT + ACT_UZ); E.VT = (bf16_t*)(ws + WS_ACT + ACT_VTA); E.stat = (float*)(ws + WS_STAT);
#ifndef SKIP_G1A
              { int nrep = REPN_G1A; asm volatile("" : "+s"(nrep));
#pragma nounroll
                for (int rep = 0; rep < nrep; ++rep) pg8::gemm_phase<EpiG1A, true, true>(lds, 1024, S, E); }
#endif
            }
            GSYNC();
#ifndef SKIP_SM
            spatial_mix(P, j, lds);
#endif
            GSYNC();
            { pg8::VSched S; S.init(nM2, 4, 4, G, cid, ws + WS_ACT + ACT_UZ, wa + WA_OUT, nullptr, 2048);
#ifndef SKIP_G2
              pg8::gemm_phase<EpiG2, true, true>(lds, 2048, S, E2);
#endif
            }
            if (layer < 3) g2_ctx_small(P, lds, (const bf16_t*)(ws + WS_ACT + ACT_UZ) + (size_t)TL * 2048, (const bf16_t*)(wa + WA_OUT), 2048, E2);
            GSYNC();
        } else {
            unsigned char* wb = ws + WS_WB0 + (size_t)j * WB_SIZE;
            { pg8::VSched S; S.init(68, 10, 9, G, cid, H, wb + WB_QKZ, wb + WB_V, 1024);
              EpiG1B E; E.Q = (bf16_t*)(ws + WS_ACT + ACT_Q); E.Kb = (bf16_t*)(ws + WS_ACT + ACT_K); E.Z = (bf16_t*)(ws + WS_ACT + ACT_Z); E.VT = (bf16_t*)(ws + WS_ACT + ACT_VTB); E.rope = (const LAS float*)(lds + 131072);
              { const int ct = opaque_tid(); *(LAS u32x4*)(lds + 131072 + ct * 16) = *(const u32x4*)(ws + WS_ROPE + ct * 16); __syncthreads(); }
#ifndef SKIP_G1B
              { int nrep = REPN_G1B; asm volatile("" : "+s"(nrep));
#pragma nounroll
                for (int rep = 0; rep < nrep; ++rep) pg8::gemm_phase<EpiG1B, true, true>(lds, 1024, S, E); }
#endif
            }
            GSYNC();
#ifndef SKIP_ATT
            attn_phase(P, j, layer < 3, lds);
#ifdef REP_ATT
            attn_phase(P, j, layer < 3, lds);
#endif
#endif
            GSYNC();
            { pg8::VSched S; S.init(nM2, 4, 4, G, cid, ws + WS_ACT + ACT_OZ, wb + WB_OUT, nullptr, 1024);
#ifndef SKIP_G2
              pg8::gemm_phase<EpiG2, true, true>(lds, 1024, S, E2);
#endif
            }
            if (layer < 3) g2_ctx_small(P, lds, (const bf16_t*)(ws + WS_ACT + ACT_OZ) + (size_t)TL * 1024, (const bf16_t*)(wb + WB_OUT), 1024, E2);
            GSYNC();
        }
#ifndef SKIP_LN
        ln_phase(P, layer);
#endif
        if (layer < 3) GSYNC();
#ifdef REP_SYNC
        GSYNC(); GSYNC(); GSYNC(); GSYNC();
#endif
    }
}

extern "C" void kernel_launch(void* const* d_in, const int* in_sizes, int n_in, void* d_out, int out_size, void* d_ws, size_t ws_size, hipStream_t stream) {
    static int grid = 0;
    if (grid == 0) {
        if (n_in != 17 || out_size != TL * DM || ws_size < WS_END) { fprintf(stderr, "kernel_launch: unexpected shapes (n_in %d out %d ws %zu)\n", n_in, out_size, ws_size); grid = -1; return; }
        int dev = 0, cus = 0, per_cu = 0;
        hipGetDevice(&dev);
        hipDeviceGetAttribute(&cus, hipDeviceAttributeMultiprocessorCount, dev);
        hipFuncSetAttribute((const void*)fwd_megakernel, hipFuncAttributeMaxDynamicSharedMemorySize, LDS_BYTES);
        hipOccupancyMaxActiveBlocksPerMultiprocessor(&per_cu, (const void*)fwd_megakernel, NTHREADS, LDS_BYTES);
        if (per_cu < 1) { fprintf(stderr, "kernel_launch: occupancy query says %d blocks/CU\n", per_cu); per_cu = 1; }
        grid = cus * per_cu;
        fprintf(stderr, "kernel_launch: cus %d per_cu %d grid %d\n", cus, per_cu, grid);
    }
    if (grid < 0) return;
    Params p{};
    p.x = (const float*)d_in[0]; p.c = (const float*)d_in[1]; p.ctx = (const float*)d_in[2]; p.c_ctx = (const float*)d_in[3];
    p.ada_w = (const float*)d_in[4]; p.ada_b = (const float*)d_in[5]; p.ln_g = (const float*)d_in[6]; p.ln_b = (const float*)d_in[7];
    p.a_w_in = (const float*)d_in[8]; p.a_ln_g = (const float*)d_in[9]; p.a_ln_b = (const float*)d_in[10]; p.a_w_s = (const float*)d_in[11]; p.a_b_s = (const float*)d_in[12]; p.a_w_out = (const float*)d_in[13];
    p.b_w_in = (const float*)d_in[14]; p.b_sink = (const float*)d_in[15]; p.b_w_out = (const float*)d_in[16];
    p.out = (float*)d_out; p.ws = (unsigned char*)d_ws;
    (void)hipMemsetAsync((char*)d_ws + WS_BAR, 0, XCD_BAR_WORDS * 4, stream);
    void* args[] = {&p};
    hipError_t e = hipLaunchCooperativeKernel((const void*)fwd_megakernel, dim3(grid), dim3(NTHREADS), args, LDS_BYTES, stream);
    if (e != hipSuccess) fprintf(stderr, "cooperative launch failed: %s (grid %d)\n", hipGetErrorString(e), grid);
}
```

```cpp
#include <hip/hip_runtime.h>
#include <cstdio>
#include <cstdint>
#ifndef REPN_G1A
#define REPN_G1A 1
#endif
#ifndef REPN_G1B
#define REPN_G1B 1
#endif

#define LAS __attribute__((address_space(3)))
#define DI __device__ __forceinline__
typedef unsigned short bf16_t;
typedef short bf16x8 __attribute__((ext_vector_type(8)));
typedef short s16x4 __attribute__((ext_vector_type(4)));
typedef float f32x2 __attribute__((ext_vector_type(2)));
typedef float f32x4 __attribute__((ext_vector_type(4)));
typedef float f32x16 __attribute__((ext_vector_type(16)));
typedef unsigned u32x2 __attribute__((ext_vector_type(2)));
typedef unsigned u32x4 __attribute__((ext_vector_type(4)));
typedef __bf16 bf16x2_t __attribute__((ext_vector_type(2)));

constexpr int DM = 1024, NB = 4, SEQ = 4096, TL = NB * SEQ, CL = 256, TC = NB * CL, T = TL + TC;
constexpr int AW = 2048;
constexpr float LN_EPS = 1e-5f;
constexpr float ALPHA = 1.681792830507429f;
constexpr float LOG2E = 1.4426950408889634f;
constexpr int NTHREADS = 512, NWAVES = 8;
constexpr int LDS_BYTES = 147456;

constexpr size_t MiB = 1u << 20;
constexpr size_t WS_MOD = 0;
constexpr size_t WS_ROPE = 262144;
constexpr size_t WS_STAT = 524288;
constexpr size_t WS_BAR = 2883584;
constexpr size_t WS_RSTAT = WS_BAR + 16384;
constexpr size_t WS_XC = 3 * MiB;
constexpr size_t WS_W = 7 * MiB;
constexpr size_t WA_UZ = 0, WA_V = 8 * MiB, WA_OUT = 12 * MiB, WA_S = 16 * MiB, WA_SIZE = 16 * MiB + 262144;
constexpr size_t WB_QKZ = 0, WB_V = 4 * MiB + 524288, WB_OUT = 5 * MiB, WB_SIZE = 7 * MiB;
constexpr size_t WS_WA0 = WS_W, WS_WB0 = WS_W + 2 * WA_SIZE;
constexpr size_t WS_H = 54 * MiB;
constexpr size_t WS_ACT = 88 * MiB;
constexpr size_t ACT_UZ = 0, ACT_VTA = 68 * MiB;
constexpr size_t ACT_Q = 0, ACT_K = 34 * MiB, ACT_VTB = 34 * MiB + 8912896, ACT_Z = 52 * MiB, ACT_OZ = 86 * MiB;
constexpr size_t WS_END = 224 * MiB;
static_assert(WS_WB0 + 2 * WB_SIZE <= WS_H, "weights fit");
static_assert((size_t)T * 256 * 2 == 8912896, "kv size");
static_assert(ACT_VTB + 8912896 <= ACT_Z && ACT_OZ + 34 * MiB <= 136 * MiB, "act map");

DI unsigned cvtpk(float lo, float hi) { f32x2 v = {lo, hi}; bf16x2_t b = __builtin_convertvector(v, bf16x2_t); return __builtin_bit_cast(unsigned, b); }
DI float bflo(unsigned u) { return __uint_as_float(u << 16); }
DI float bfhi(unsigned u) { return __uint_as_float(u & 0xffff0000u); }
DI float fast_sigmoid(float t) { return __builtin_amdgcn_rcpf(1.0f + __builtin_amdgcn_exp2f(-LOG2E * t)); }
DI float gelu_t(float x) { const float t = x * (1.5957691216057308f + 0.07135481627183409f * x * x); return x * fast_sigmoid(t); }
DI float silu_f(float x) { return x * fast_sigmoid(x); }
typedef _Float16 h16x2 __attribute__((ext_vector_type(2)));
DI unsigned pkh(float lo, float hi) { const h16x2 v = {(_Float16)lo, (_Float16)hi}; return __builtin_bit_cast(unsigned, v); }
DI float hlo(unsigned u) { return (float)__builtin_bit_cast(h16x2, u).x; }
DI float hhi(unsigned u) { return (float)__builtin_bit_cast(h16x2, u).y; }
DI int opaque_tid() { int t = threadIdx.x; asm volatile("" : "+v"(t)); return t; }
template <int CTRL> DI float dpp_add(float v) { return v + __builtin_bit_cast(float, __builtin_amdgcn_update_dpp(0, __builtin_bit_cast(int, v), CTRL, 0xf, 0xf, false)); }
DI float max3f(float a, float b, float c) { float r; asm("v_max3_f32 %0, %1, %2, %3" : "=v"(r) : "v"(a), "v"(b), "v"(c)); return r; }
DI f32x2 exp2_2(f32x2 v) { return (f32x2){__builtin_amdgcn_exp2f(v.x), __builtin_amdgcn_exp2f(v.y)}; }
DI f32x2 rcp_2(f32x2 v) { return (f32x2){__builtin_amdgcn_rcpf(v.x), __builtin_amdgcn_rcpf(v.y)}; }
constexpr float GELU_A = -1.5957691216057308f * LOG2E, GELU_B = -0.07135481627183409f * LOG2E;
DI f32x2 gelu_silu_pk(f32x2 u, f32x2 z) { const f32x2 p = (u * u) * GELU_B + GELU_A; const f32x2 e1 = exp2_2(u * p), e2 = exp2_2(z * (-LOG2E)); return (u * z) * rcp_2((e1 + 1.0f) * (e2 + 1.0f)); }
DI f32x2 gelu_pk2(f32x2 u) { const f32x2 p = (u * u) * GELU_B + GELU_A; return u * rcp_2(exp2_2(u * p) + 1.0f); }
DI f32x2 silu_pk2(f32x2 z) { return z * rcp_2(exp2_2(z * (-LOG2E)) + 1.0f); }
DI float xhalf_f(float v) { const unsigned u = __builtin_bit_cast(unsigned, v);
#if __has_builtin(__builtin_amdgcn_permlane32_swap)
    const auto r = __builtin_amdgcn_permlane32_swap(u, u, false, false); const unsigned lo = r[0], hi = r[1];
    return __builtin_bit_cast(float, (threadIdx.x & 32) ? lo : hi);
#else
    return __shfl_xor(v, 32);
#endif
}
DI float wave_sum_dpp(float v) {
    v = dpp_add<0xB1>(v); v = dpp_add<0x4E>(v); v = dpp_add<0x141>(v); v = dpp_add<0x140>(v);
    v += __shfl_xor(v, 16); v += __shfl_xor(v, 32);
    return v;
}
DI float wave_sum(float v) {
#pragma unroll
    for (int o = 1; o < 64; o <<= 1) v += __shfl_xor(v, o);
    return v;
}

namespace pg8 {
#define PG8_LAS __attribute__((address_space(3)))
constexpr int BM = 256, BK = 64, HALF = 128, HTB = HALF * BK * 2, STAGE_BYTES = 8 * HTB, NXCD = 8, WGM = 8;
__host__ __device__ __forceinline__ int lds_byte(int r, int c) { const int st = (r >> 4) * 2 + (c >> 5), rr = r & 15, cc = c & 31, ob = rr * 64 + cc * 2; return st * 1024 + (ob ^ (((ob >> 9) & 1) << 5)); }
__host__ __device__ __forceinline__ void stage_rc(int b, int& R, int& C) { const int st = b / 1024, sb = b % 1024, swz = sb ^ (((sb >> 9) & 1) << 5); R = (st >> 1) * 16 + swz / 64; C = (st & 1) * 32 + (swz % 64) / 2; }
__host__ __device__ __forceinline__ int perm32(int rho) { const int n = rho >> 4, i = rho & 15; return 8 * (i >> 2) + 4 * n + (i & 3); }

struct Unit { int pm, pn; };

struct VSched {
    int nM, nN, nwg, G, c, nsplit; const char* A0; const char* B0; const char* A1; size_t tstep;
    DI void init(int nM_, int nN_, int nsplit_, int G_, int c_, const void* a0, const void* b0, const void* a1, int K) {
        nM = nM_; nN = nN_; nwg = nM * nN; G = G_; c = c_; nsplit = nsplit_; A0 = (const char*)a0; B0 = (const char*)b0; A1 = (const char*)a1; tstep = (size_t)BM * K * 2; }
    DI bool next(int i, Unit& u) const {
        const long L = (long)i * G + c; if (L >= nwg) return false;
        int wgid = (int)L; { const int q = nwg / NXCD, r = nwg % NXCD, xcd = wgid % NXCD, off = wgid / NXCD; wgid = (xcd < r ? xcd * (q + 1) : r * (q + 1) + (xcd - r) * q) + off; }
        const int nig = WGM * nN, gid = wgid / nig, fm = gid * WGM, gsz = (nM - fm) < WGM ? (nM - fm) : WGM;
        u.pm = fm + ((wgid % nig) % gsz); u.pn = (wgid % nig) / gsz; return true;
    }
    DI const char* pa(const Unit& u) const { return u.pn < nsplit ? A0 + (size_t)u.pm * tstep : A1 + (size_t)(u.pn - nsplit) * tstep; }
    DI const char* pb(const Unit& u) const { return u.pn < nsplit ? B0 + (size_t)u.pn * tstep : A0 + (size_t)u.pm * tstep; }
};

template <class Epi, bool ALIGN_EPI, bool SP2>
__device__ __forceinline__ void gemm_phase(PG8_LAS unsigned char* lds, const int K, const VSched& S, const Epi& E) {
    const int tid = opaque_tid(), wid = __builtin_amdgcn_readfirstlane(tid >> 6), lane = tid & 63, wr = wid >> 2, wc = wid & 3, fr = lane & 15, fq = lane >> 4;
    const int nt = K / BK;
    unsigned voffA[2], voffB[2];
#pragma unroll
    for (int i = 0; i < 2; ++i) { int R, C; stage_rc(tid * 16 + i * 8192, R, C); const int Rb = Epi::PERM ? ((R & ~31) + perm32(R & 31)) : R;
        voffA[i] = (unsigned)(R * K + C) * 2u; voffB[i] = (unsigned)(Rb * K + C) * 2u; }
    const size_t kstep = (size_t)(BK * 2);
    const size_t hstep = (size_t)HALF * K * 2;
    const unsigned ldsw = (unsigned)wid * 1024u;
    const int aoff = lds_byte(wr * 64 + fr, fq * 8), boff = lds_byte(wc * 32 + fr, fq * 8);
#define PG8_SA(b, h) (((b) * 2 + (h)) * HTB)
#define PG8_SB(b, h) ((4 + (b) * 2 + (h)) * HTB)
#define PG8_STAGE(bufoff, gbase, voff) do { _Pragma("unroll") for (int _i = 0; _i < 2; ++_i) \
        __builtin_amdgcn_global_load_lds((const unsigned*)((const char*)(gbase) + (voff)[_i]), (PG8_LAS unsigned*)(lds + (bufoff) + ldsw + _i * 8192), 16, 0, 0); } while (0)
#define PG8_LDA(dst, b, h) do { _Pragma("unroll") for (int m = 0; m < 4; ++m) _Pragma("unroll") for (int k = 0; k < 2; ++k) dst[m][k] = *(const PG8_LAS bf16x8*)(lds + PG8_SA(b, h) + aoff + m * 2048 + k * 1024); } while (0)
#define PG8_LDB(dst, b, h) do { _Pragma("unroll") for (int n = 0; n < 2; ++n) _Pragma("unroll") for (int k = 0; k < 2; ++k) dst[n][k] = *(const PG8_LAS bf16x8*)(lds + PG8_SB(b, h) + boff + n * 2048 + k * 1024); } while (0)
#define PG8_MMA(ai, bj, At, Bt) do { __builtin_amdgcn_s_setprio(1); _Pragma("unroll") for (int m = 0; m < 4; ++m) _Pragma("unroll") for (int n = 0; n < 2; ++n) _Pragma("unroll") for (int k = 0; k < 2; ++k) \
        acc[ai][bj][m][n] = __builtin_amdgcn_mfma_f32_16x16x32_bf16(Bt[n][k], At[m][k], acc[ai][bj][m][n], 0, 0, 0); __builtin_amdgcn_s_setprio(0); } while (0)
#define PG8_WAIT_V(n) asm volatile("s_waitcnt vmcnt(" #n ")" ::: "memory")
#define PG8_WAIT_L(n) asm volatile("s_waitcnt lgkmcnt(" #n ")" ::: "memory")
#define PG8_BAR __builtin_amdgcn_s_barrier()
#define PG8_SCHED __builtin_amdgcn_sched_barrier(0)
    Unit cur, nxt; int ui = 0;
    if (!S.next(0, cur)) return;
    f32x4 acc[2][2][4][2];
#pragma unroll
    for (int a = 0; a < 2; ++a)
#pragma unroll
        for (int b = 0; b < 2; ++b)
#pragma unroll
            for (int m = 0; m < 4; ++m)
#pragma unroll
                for (int n = 0; n < 2; ++n) acc[a][b][m][n] = (f32x4){0.f, 0.f, 0.f, 0.f};
    bf16x8 At[4][2], B0[2][2], B1[2][2];
    const char* cA = S.pa(cur); const char* cB = S.pb(cur);
    if constexpr (SP2) {
        PG8_STAGE(PG8_SB(0, 0), cB, voffB); PG8_STAGE(PG8_SB(0, 1), cB + hstep, voffB); PG8_STAGE(PG8_SA(0, 0), cA, voffA); PG8_STAGE(PG8_SA(0, 1), cA + hstep, voffA);
        if (wr == 1) PG8_BAR;
        PG8_WAIT_V(2); PG8_BAR;
        PG8_STAGE(PG8_SB(1, 0), cB + kstep, voffB); PG8_STAGE(PG8_SA(1, 0), cA + kstep, voffA); PG8_STAGE(PG8_SB(1, 1), cB + hstep + kstep, voffB);
        PG8_WAIT_V(6); PG8_BAR;
    } else {
        PG8_STAGE(PG8_SB(0, 0), cB, voffB); PG8_STAGE(PG8_SA(0, 0), cA, voffA); PG8_STAGE(PG8_SB(0, 1), cB + hstep, voffB); PG8_STAGE(PG8_SA(0, 1), cA + hstep, voffA);
        if (wr == 1) PG8_BAR;
        PG8_WAIT_V(4); PG8_BAR;
        PG8_STAGE(PG8_SB(1, 0), cB + kstep, voffB); PG8_STAGE(PG8_SA(1, 0), cA + kstep, voffA); PG8_STAGE(PG8_SB(1, 1), cB + hstep + kstep, voffB);
        PG8_WAIT_V(6); PG8_BAR;
    }
    for (;;) {
        const bool has_next = S.next(ui + 1, nxt);
        const char* nA = has_next ? S.pa(nxt) : cA; const char* nB = has_next ? S.pb(nxt) : cB;
        for (int t = 0; t < nt; t += 2) {
            const bool last = (t == nt - 2);
            const char* a1 = cA + (size_t)(t + 1) * kstep;
            const char* a2 = last ? nA : cA + (size_t)(t + 2) * kstep; const char* b2 = last ? nB : cB + (size_t)(t + 2) * kstep;
            const char* a3 = a2 + kstep; const char* b3 = b2 + kstep;
            if constexpr (SP2) {
            PG8_LDB(B0, 0, 0); PG8_LDB(B1, 0, 1); PG8_SCHED; PG8_LDA(At, 0, 0); PG8_STAGE(PG8_SA(1, 1), a1 + hstep, voffA);
            PG8_WAIT_V(8); PG8_WAIT_L(0); PG8_BAR; PG8_MMA(0, 0, At, B0); PG8_MMA(0, 1, At, B1); PG8_BAR; PG8_SCHED;
            PG8_LDA(At, 0, 1); PG8_STAGE(PG8_SB(0, 0), b2, voffB); PG8_STAGE(PG8_SB(0, 1), b2 + hstep, voffB); PG8_STAGE(PG8_SA(0, 0), a2, voffA);
            PG8_WAIT_V(8); PG8_WAIT_L(0); PG8_BAR; PG8_MMA(1, 0, At, B0); PG8_MMA(1, 1, At, B1); PG8_BAR; PG8_SCHED;
            PG8_LDB(B0, 1, 0); PG8_LDB(B1, 1, 1); PG8_SCHED; PG8_LDA(At, 1, 0); PG8_STAGE(PG8_SA(0, 1), a2 + hstep, voffA);
            PG8_WAIT_V(8); PG8_WAIT_L(0); PG8_BAR; PG8_MMA(0, 0, At, B0); PG8_MMA(0, 1, At, B1); PG8_BAR; PG8_SCHED;
            PG8_LDA(At, 1, 1); PG8_STAGE(PG8_SB(1, 0), b3, voffB); PG8_STAGE(PG8_SB(1, 1), b3 + hstep, voffB); PG8_STAGE(PG8_SA(1, 0), a3, voffA);
            PG8_WAIT_V(8); PG8_WAIT_L(0); PG8_BAR; PG8_MMA(1, 0, At, B0); PG8_MMA(1, 1, At, B1); PG8_BAR; PG8_SCHED;
            } else {
            PG8_LDB(B0, 0, 0); PG8_SCHED; PG8_LDA(At, 0, 0); PG8_STAGE(PG8_SA(1, 1), a1 + hstep, voffA);
            PG8_WAIT_L(8); PG8_BAR; PG8_WAIT_L(0); PG8_MMA(0, 0, At, B0); PG8_BAR; PG8_SCHED;
            PG8_LDB(B1, 0, 1); PG8_STAGE(PG8_SB(0, 0), b2, voffB);
            PG8_BAR; PG8_WAIT_L(0); PG8_MMA(0, 1, At, B1); PG8_BAR;
            PG8_LDA(At, 0, 1); PG8_STAGE(PG8_SA(0, 0), a2, voffA);
            PG8_BAR; PG8_WAIT_L(0); PG8_MMA(1, 0, At, B0); PG8_BAR; PG8_SCHED;
            PG8_STAGE(PG8_SB(0, 1), b2 + hstep, voffB);
            PG8_WAIT_V(6); PG8_BAR; PG8_MMA(1, 1, At, B1); PG8_BAR;
            PG8_LDB(B0, 1, 0); PG8_SCHED; PG8_LDA(At, 1, 0); PG8_STAGE(PG8_SA(0, 1), a2 + hstep, voffA);
            PG8_WAIT_L(8); PG8_BAR; PG8_WAIT_L(0); PG8_MMA(0, 0, At, B0); PG8_BAR; PG8_SCHED;
            PG8_LDB(B1, 1, 1); PG8_STAGE(PG8_SB(1, 0), b3, voffB);
            PG8_BAR; PG8_WAIT_L(0); PG8_MMA(0, 1, At, B1); PG8_BAR;
            PG8_LDA(At, 1, 1); PG8_STAGE(PG8_SA(1, 0), a3, voffA);
            PG8_BAR; PG8_WAIT_L(0); PG8_MMA(1, 0, At, B0); PG8_BAR; PG8_SCHED;
            PG8_STAGE(PG8_SB(1, 1), b3 + hstep, voffB);
            PG8_WAIT_V(6); PG8_BAR; PG8_MMA(1, 1, At, B1); PG8_BAR;
            }
        }
        if constexpr (ALIGN_EPI) { if (wr == 0) PG8_BAR; }
        { int fr2 = fr, fq2 = fq; asm volatile("" : "+v"(fr2), "+v"(fq2)); E(acc, cur, wr, wc, fr2, fq2); }
        if (!has_next) break;
#pragma unroll
        for (int a = 0; a < 2; ++a)
#pragma unroll
            for (int b = 0; b < 2; ++b)
#pragma unroll
                for (int m = 0; m < 4; ++m)
#pragma unroll
                    for (int n = 0; n < 2; ++n) acc[a][b][m][n] = (f32x4){0.f, 0.f, 0.f, 0.f};
        cur = nxt; cA = nA; cB = nB; ++ui;
        if constexpr (ALIGN_EPI) { if (wr == 1) PG8_BAR; }
    }
    PG8_WAIT_V(0);
    if constexpr (!ALIGN_EPI) { if (wr == 0) PG8_BAR; }
    PG8_BAR;
#undef PG8_SA
#undef PG8_SB
#undef PG8_STAGE
#undef PG8_LDA
#undef PG8_LDB
#undef PG8_MMA
#undef PG8_WAIT_V
#undef PG8_WAIT_L
#undef PG8_BAR
#undef PG8_SCHED
}
}
using pg8::Unit;

struct EpiG1A {
    static constexpr bool PERM = true;
    bf16_t* UZ; bf16_t* VT; float* stat;
    DI void operator()(const f32x4 (&acc)[2][2][4][2], const Unit& u, int wr, int wc, int fr, int fq) const {
        if (u.pn < 16) {
#ifndef NO_UZ
            const int row0 = u.pm * 256 + wr * 64 + fr, col0 = u.pn * 128 + wc * 32 + 8 * fq;
#pragma unroll
            for (int ai = 0; ai < 2; ++ai)
#pragma unroll
                for (int m = 0; m < 4; ++m) {
                    const f32x4 u0 = acc[ai][0][m][0], u1 = acc[ai][0][m][1], z0 = acc[ai][1][m][0], z1 = acc[ai][1][m][1];
                    const f32x2 oa = gelu_silu_pk((f32x2){u0[0], u0[1]}, (f32x2){z0[0], z0[1]}), ob = gelu_silu_pk((f32x2){u0[2], u0[3]}, (f32x2){z0[2], z0[3]});
                    const f32x2 oc = gelu_silu_pk((f32x2){u1[0], u1[1]}, (f32x2){z1[0], z1[1]}), od = gelu_silu_pk((f32x2){u1[2], u1[3]}, (f32x2){z1[2], z1[3]});
                    u32x4 w; w.x = cvtpk(oa.x, oa.y); w.y = cvtpk(ob.x, ob.y); w.z = cvtpk(oc.x, oc.y); w.w = cvtpk(od.x, od.y);
                    *(u32x4*)(UZ + (size_t)(row0 + ai * 128 + m * 16) * AW + col0) = w;
                }
#endif
        } else {
#ifndef NO_VT
            const int ct = u.pn - 16;
            const int ch0 = ct * 256 + wr * 64 + fr, tok0 = u.pm * 256 + wc * 32 + 8 * fq;
            float one = 1.0f; asm volatile("" : "+v"(one));
#pragma unroll
            for (int bj = 0; bj < 2; ++bj) {
                float s1[8], s2[8];
#pragma unroll
                for (int t = 0; t < 8; ++t) { s1[t] = 0.f; s2[t] = 0.f; }
#pragma unroll
                for (int ai = 0; ai < 2; ++ai)
#pragma unroll
                    for (int m = 0; m < 4; ++m) {
                        float g[8];
#pragma unroll
                        for (int j = 0; j < 4; ++j) { g[j] = gelu_t(acc[ai][bj][m][0][j] * one); g[4 + j] = gelu_t(acc[ai][bj][m][1][j] * one); }
#pragma unroll
                        for (int j = 0; j < 8; ++j) { s1[j] += g[j]; s2[j] += g[j] * g[j]; }
                        u32x4 w; w.x = cvtpk(g[0], g[1]); w.y = cvtpk(g[2], g[3]); w.z = cvtpk(g[4], g[5]); w.w = cvtpk(g[6], g[7]);
                        *(u32x4*)(VT + (size_t)(ch0 + ai * 128 + m * 16) * T + tok0 + bj * 128) = w;
                    }
#pragma unroll
                for (int k = 0; k < 8; ++k) {
                    s1[k] = dpp_add<0xB1>(s1[k]); s2[k] = dpp_add<0xB1>(s2[k]);
                    s1[k] = dpp_add<0x4E>(s1[k]); s2[k] = dpp_add<0x4E>(s2[k]);
                    s1[k] = dpp_add<0x141>(s1[k]); s2[k] = dpp_add<0x141>(s2[k]);
                    s1[k] = dpp_add<0x140>(s1[k]); s2[k] = dpp_add<0x140>(s2[k]); }
#pragma unroll
                for (int k = 1; k < 8; ++k) { s1[0] = (fr == k) ? s1[k] : s1[0]; s2[0] = (fr == k) ? s2[k] : s2[0]; }
                if (fr < 8) { const int tok = tok0 + bj * 128 + fr;
                    *(f32x2*)(stat + ((size_t)tok * 16 + ct * 2 + wr) * 2) = (f32x2){s1[0], s2[0]}; }
            }
#endif
        }
    }
};

struct EpiG1B {
    static constexpr bool PERM = true;
    bf16_t* Q; bf16_t* Kb; bf16_t* Z; bf16_t* VT; const LAS float* rope;
    DI void operator()(const f32x4 (&acc)[2][2][4][2], const Unit& u, int wr, int wc, int fr, int fq) const {
        if (u.pn <= 4) {
            const bool isq = u.pn < 4, latent = u.pm < 64;
            const float sc = isq ? 0.125f * LOG2E : 1.0f;
            const int axis = wc & 1, f0 = 8 * (fq & 1);
            const float sgn = (fq < 2) ? -1.f : 1.f;
            bf16_t* base = isq ? Q + u.pn * 256 : Kb; const int ld = isq ? 1024 : 256;
#pragma unroll
            for (int ai = 0; ai < 2; ++ai)
#pragma unroll
                for (int m = 0; m < 4; ++m) {
                    const int row = u.pm * 256 + ai * 128 + wr * 64 + m * 16 + fr;
                    const int t = row & 4095, pos = axis ? (t & 63) : (t >> 6);
                    f32x4 c0 = {1.f, 1.f, 1.f, 1.f}, c1 = c0, s0 = {0.f, 0.f, 0.f, 0.f}, s1 = s0;
                    if (latent) { const LAS float* cp = rope + pos * 16 + f0; c0 = *(const LAS f32x4*)cp; c1 = *(const LAS f32x4*)(cp + 4); s0 = *(const LAS f32x4*)(cp + 1024); s1 = *(const LAS f32x4*)(cp + 1028); }
#pragma unroll
                    for (int bj = 0; bj < 2; ++bj) {
                        const f32x4 v0 = acc[ai][bj][m][0], v1 = acc[ai][bj][m][1];
                        float o[8];
#pragma unroll
                        for (int j = 0; j < 4; ++j) {
                            const float p0 = __shfl_xor(v0[j], 32), p1 = __shfl_xor(v1[j], 32);
                            o[j] = (v0[j] * c0[j] + sgn * p0 * s0[j]) * sc; o[4 + j] = (v1[j] * c1[j] + sgn * p1 * s1[j]) * sc; }
                        u32x4 w; w.x = cvtpk(o[0], o[1]); w.y = cvtpk(o[2], o[3]); w.z = cvtpk(o[4], o[5]); w.w = cvtpk(o[6], o[7]);
                        *(u32x4*)(base + (size_t)row * ld + bj * 128 + wc * 32 + 8 * fq) = w;
                    }
                }
        } else if (u.pn < 9) {
            bf16_t* base = Z + (u.pn - 5) * 256 + wc * 32 + 8 * fq;
#pragma unroll
            for (int ai = 0; ai < 2; ++ai)
#pragma unroll
                for (int m = 0; m < 4; ++m) {
                    const int row = u.pm * 256 + ai * 128 + wr * 64 + m * 16 + fr;
#pragma unroll
                    for (int bj = 0; bj < 2; ++bj) {
                        const f32x4 v0 = acc[ai][bj][m][0], v1 = acc[ai][bj][m][1];
                        const f32x2 sa = silu_pk2((f32x2){v0[0], v0[1]}), sb = silu_pk2((f32x2){v0[2], v0[3]}), sc2 = silu_pk2((f32x2){v1[0], v1[1]}), sd = silu_pk2((f32x2){v1[2], v1[3]});
                        u32x4 w; w.x = cvtpk(sa.x, sa.y); w.y = cvtpk(sb.x, sb.y); w.z = cvtpk(sc2.x, sc2.y); w.w = cvtpk(sd.x, sd.y);
                        *(u32x4*)(base + (size_t)row * 1024 + bj * 128) = w;
                    }
                }
        } else {
            const int tok0 = u.pm * 256 + wc * 32 + 8 * fq;
#pragma unroll
            for (int ai = 0; ai < 2; ++ai)
#pragma unroll
                for (int m = 0; m < 4; ++m) {
                    const int ch = ai * 128 + wr * 64 + m * 16 + fr;
#pragma unroll
                    for (int bj = 0; bj < 2; ++bj) {
                        const f32x4 v0 = acc[ai][bj][m][0], v1 = acc[ai][bj][m][1];
                        u32x4 w; w.x = cvtpk(v0[0], v0[1]); w.y = cvtpk(v0[2], v0[3]); w.z = cvtpk(v1[0], v1[1]); w.w = cvtpk(v1[2], v1[3]);
                        *(u32x4*)(VT + (size_t)ch * T + tok0 + bj * 128) = w;
                    }
                }
        }
    }
};

struct EpiG2 {
    static constexpr bool PERM = true;
    const float* x0; const unsigned short* rsrc; unsigned short* rdst;
    const float* xc0; unsigned short* rc;
    const float* gate; const float* rstat; const float* png; const float* pnb;
    DI void operator()(const f32x4 (&acc)[2][2][4][2], const Unit& u, int wr, int wc, int fr, int fq) const {
        const bool norm = x0 == nullptr;
        const int cb = u.pn * 256 + wc * 32 + 8 * fq;
        const float* gp = gate + (u.pm >> 4) * 3072 + cb;
        const int rbase = u.pm * 256 + wr * 64 + fr;
        const float* sp = rstat + (size_t)rbase * 2;
#pragma unroll
        for (int bj = 0; bj < 2; ++bj) {
            const int co = bj * 128;
            const f32x4 g0 = *(const f32x4*)(gp + co), g1 = *(const f32x4*)(gp + co + 4);
            f32x4 ng0 = {1.f, 1.f, 1.f, 1.f}, ng1 = ng0, nb0 = {0.f, 0.f, 0.f, 0.f}, nb1 = nb0;
            if (norm) { ng0 = *(const f32x4*)(png + cb + co); ng1 = *(const f32x4*)(png + cb + co + 4); nb0 = *(const f32x4*)(pnb + cb + co); nb1 = *(const f32x4*)(pnb + cb + co + 4); }
#pragma unroll
            for (int ai = 0; ai < 2; ++ai) {
                f32x4 xa[4], xb[4];
                if (norm) { u32x4 rv[4]; f32x2 st[4];
#pragma unroll
                    for (int m = 0; m < 4; ++m) { const int ro = ai * 128 + m * 16; rv[m] = *(const u32x4*)(rsrc + (size_t)(rbase + ro) * DM + cb + co); st[m] = *(const f32x2*)(sp + ro * 2); }
#pragma unroll
                    for (int m = 0; m < 4; ++m) { xa[m] = (f32x4){hlo(rv[m].x), hhi(rv[m].x), hlo(rv[m].y), hhi(rv[m].y)}; xb[m] = (f32x4){hlo(rv[m].z), hhi(rv[m].z), hlo(rv[m].w), hhi(rv[m].w)};
                        xa[m] = (xa[m] - st[m].x) * st[m].y * ng0 + nb0; xb[m] = (xb[m] - st[m].x) * st[m].y * ng1 + nb1; } }
                else {
#pragma unroll
                    for (int m = 0; m < 4; ++m) { const size_t off = (size_t)(rbase + ai * 128 + m * 16) * DM + cb + co;
                        xa[m] = __builtin_nontemporal_load((const f32x4*)(x0 + off)); xb[m] = __builtin_nontemporal_load((const f32x4*)(x0 + off + 4)); } }
#pragma unroll
                for (int m = 0; m < 4; ++m) { const size_t off = (size_t)(rbase + ai * 128 + m * 16) * DM + cb + co;
                    const f32x4 ra = xa[m] * ALPHA + g0 * acc[ai][bj][m][0], rb = xb[m] * ALPHA + g1 * acc[ai][bj][m][1];
                    u32x4 w; w.x = pkh(ra[0], ra[1]); w.y = pkh(ra[2], ra[3]); w.z = pkh(rb[0], rb[1]); w.w = pkh(rb[2], rb[3]);
                    *(u32x4*)(rdst + off) = w; }
            }
        }
    }
};

struct Params {
    const float* x; const float* c; const float* ctx; const float* c_ctx; const float* ada_w; const float* ada_b; const float* ln_g; const float* ln_b;
    const float* a_w_in; const float* a_ln_g; const float* a_ln_b; const float* a_w_s; const float* a_b_s; const float* a_w_out;
    const float* b_w_in; const float* b_sink; const float* b_w_out;
    float* out; unsigned char* ws;
};


DI void g2_ctx_small(const Params& P, LAS unsigned char* lds, const bf16_t* A  , const bf16_t* Bt, const int K, const EpiG2& E) {
    const int tid = opaque_tid(), lane = tid & 63, wave = __builtin_amdgcn_readfirstlane(tid >> 6);
    const int r16 = lane & 15, kq = lane >> 4;
    const int kw = K >> 3;
    LAS float* part = (LAS float*)lds;
    for (int tile = blockIdx.x; tile < 256; tile += gridDim.x) {
        const int tm = tile >> 4, tn = tile & 15;
        const bf16_t* ap = A + (size_t)(64 * tm + r16) * K + wave * kw + 8 * kq;
        const bf16_t* bp = Bt + (size_t)(64 * tn + r16) * K + wave * kw + 8 * kq;
        f32x4 acc[4][4];
#pragma unroll
        for (int i = 0; i < 4; ++i)
#pragma unroll
            for (int jj = 0; jj < 4; ++jj) acc[i][jj] = (f32x4){0.f, 0.f, 0.f, 0.f};
        bf16x8 a[2][4], b[2][4];
#pragma unroll
        for (int i = 0; i < 4; ++i) { a[0][i] = *(const bf16x8*)(ap + (size_t)(16 * i) * K); b[0][i] = *(const bf16x8*)(bp + (size_t)(16 * i) * K); }
#pragma unroll 1
        for (int k0 = 0; k0 < kw; k0 += 64) {
#pragma unroll
            for (int i = 0; i < 4; ++i) { a[1][i] = *(const bf16x8*)(ap + (size_t)(16 * i) * K + k0 + 32); b[1][i] = *(const bf16x8*)(bp + (size_t)(16 * i) * K + k0 + 32); }
#pragma unroll
            for (int i = 0; i < 4; ++i)
#pragma unroll
                for (int jj = 0; jj < 4; ++jj) acc[i][jj] = __builtin_amdgcn_mfma_f32_16x16x32_bf16(a[0][i], b[0][jj], acc[i][jj], 0, 0, 0);
            const int kn = (k0 + 64 < kw) ? (k0 + 64) : (kw - 32);
#pragma unroll
            for (int i = 0; i < 4; ++i) { a[0][i] = *(const bf16x8*)(ap + (size_t)(16 * i) * K + kn); b[0][i] = *(const bf16x8*)(bp + (size_t)(16 * i) * K + kn); }
#pragma unroll
            for (int i = 0; i < 4; ++i)
#pragma unroll
                for (int jj = 0; jj < 4; ++jj) acc[i][jj] = __builtin_amdgcn_mfma_f32_16x16x32_bf16(a[1][i], b[1][jj], acc[i][jj], 0, 0, 0);
        }
        __syncthreads();
#pragma unroll
        for (int i = 0; i < 4; ++i)
#pragma unroll
            for (int jj = 0; jj < 4; ++jj)
#pragma unroll
                for (int q = 0; q < 4; ++q) part[wave * 4096 + (16 * i + 4 * kq + q) * 64 + 16 * jj + r16] = acc[i][jj][q];
        __syncthreads();
        { const int row = tid >> 3, c0 = (tid & 7) * 8;
          f32x4 s0 = {0.f, 0.f, 0.f, 0.f}, s1 = s0;
#pragma unroll
          for (int w = 0; w < 8; ++w) { s0 += *(const LAS f32x4*)(part + w * 4096 + row * 64 + c0); s1 += *(const LAS f32x4*)(part + w * 4096 + row * 64 + c0 + 4); }
          const int crow = 64 * tm + row, col = 64 * tn + c0;
          const float* gp = E.gate + 4 * 3072 + col;
          const size_t off = (size_t)crow * DM + col;
          f32x4 x0, x1;
          if (E.xc0 != nullptr) { x0 = *(const f32x4*)(E.xc0 + off); x1 = *(const f32x4*)(E.xc0 + off + 4); }
          else { const u32x4 rv = *(const u32x4*)(E.rc + off); const f32x2 st = *(const f32x2*)(E.rstat + (size_t)(TL + crow) * 2);
              x0 = (f32x4){hlo(rv.x), hhi(rv.x), hlo(rv.y), hhi(rv.y)}; x1 = (f32x4){hlo(rv.z), hhi(rv.z), hlo(rv.w), hhi(rv.w)};
              x0 = (x0 - st.x) * st.y * *(const f32x4*)(E.png + col) + *(const f32x4*)(E.pnb + col);
              x1 = (x1 - st.x) * st.y * *(const f32x4*)(E.png + col + 4) + *(const f32x4*)(E.pnb + col + 4); }
          const f32x4 ra = x0 * ALPHA + *(const f32x4*)gp * s0, rb = x1 * ALPHA + *(const f32x4*)(gp + 4) * s1;
          u32x4 w; w.x = pkh(ra[0], ra[1]); w.y = pkh(ra[2], ra[3]); w.z = pkh(rb[0], rb[1]); w.w = pkh(rb[2], rb[3]);
          *(u32x4*)(E.rc + off) = w; }
    }
    __syncthreads();
}

DI void transpose_item(const float* W, int N, int K, bf16_t* WTrow  , int k0, int n0, LAS float* scr, int lane) {
    f32x4 tv[8];
#pragma unroll
    for (int i = 0; i < 8; ++i) tv[i] = __builtin_nontemporal_load((const f32x4*)(W + (size_t)(k0 + 8 * i + (lane >> 3)) * N + n0 + 4 * (lane & 7)));
#pragma unroll
    for (int i = 0; i < 8; ++i) { LAS float* d = scr + (8 * i + (lane >> 3)) * 33 + 4 * (lane & 7); d[0] = tv[i][0]; d[1] = tv[i][1]; d[2] = tv[i][2]; d[3] = tv[i][3]; }
    asm volatile("s_waitcnt lgkmcnt(0)" ::: "memory");
    const int c = lane & 7;
#pragma unroll
    for (int j = 0; j < 4; ++j) { const int n = (lane >> 3) + 8 * j; const LAS float* s = scr + (8 * c) * 33 + n;
        u32x4 o; o.x = cvtpk(s[0 * 33], s[1 * 33]); o.y = cvtpk(s[2 * 33], s[3 * 33]); o.z = cvtpk(s[4 * 33], s[5 * 33]); o.w = cvtpk(s[6 * 33], s[7 * 33]);
        *(u32x4*)(WTrow + (size_t)n * K + k0 + 8 * c) = o; }
    asm volatile("s_waitcnt lgkmcnt(0)" ::: "memory");
}

DI void p0_prologue(const Params& P, LAS unsigned char* lds) {
    const int tid = opaque_tid(), lane = tid & 63, wave = __builtin_amdgcn_readfirstlane(tid >> 6);
    unsigned char* ws = P.ws;
    {
        LAS float* scond = (LAS float*)lds;
        LAS float* red = (LAS float*)(lds + 32768);
        for (int idx = tid; idx < 5 * 1024; idx += NTHREADS) { const int r = idx >> 10, k = idx & 1023; const float v = r < 4 ? P.c[r * 1024 + k] : P.c_ctx[k]; scond[idx] = silu_f(v); }
        __syncthreads();
        for (int item = blockIdx.x; item < 192; item += gridDim.x) {
            const int li = item / 48, cc = item % 48, n = cc * 64 + lane;
            const float* wp = P.ada_w + (size_t)li * 1024 * 3072 + (size_t)(wave * 128) * 3072 + n;
            float a0 = 0.f, a1 = 0.f, a2 = 0.f, a3 = 0.f, a4 = 0.f;
#pragma unroll 1
            for (int kb = 0; kb < 128; kb += 32) {
                float wv[32];
#pragma unroll
                for (int k = 0; k < 32; ++k) wv[k] = __builtin_nontemporal_load(wp + (size_t)(kb + k) * 3072);
#pragma unroll
                for (int k = 0; k < 32; ++k) { const float w = wv[k]; const int kk = wave * 128 + kb + k;
                    a0 += scond[kk] * w; a1 += scond[1024 + kk] * w; a2 += scond[2048 + kk] * w; a3 += scond[3072 + kk] * w; a4 += scond[4096 + kk] * w; } }
            red[(wave * 5 + 0) * 64 + lane] = a0; red[(wave * 5 + 1) * 64 + lane] = a1; red[(wave * 5 + 2) * 64 + lane] = a2; red[(wave * 5 + 3) * 64 + lane] = a3; red[(wave * 5 + 4) * 64 + lane] = a4;
            __syncthreads();
            if (tid < 320) { const int r = tid >> 6, l = tid & 63; float s = P.ada_b[li * 3072 + cc * 64 + l];
#pragma unroll
                for (int w = 0; w < 8; ++w) s += red[(w * 5 + r) * 64 + l];
                ((float*)(ws + WS_MOD))[(li * 5 + r) * 3072 + cc * 64 + l] = s; }
            __syncthreads();
        }
    }
    if (blockIdx.x == gridDim.x - 1) {
        float* rope = (float*)(ws + WS_ROPE);
        for (int idx = tid; idx < 1024; idx += NTHREADS) { const int pos = idx >> 4, f = idx & 15;
            const float inv = exp2f(-(float)f * (13.287712379549449f / 16.0f)); const float ang = (float)pos * inv;
            rope[idx] = __cosf(ang); rope[1024 + idx] = __sinf(ang); }
    }
    __syncthreads();
    {
        LAS float* scr = (LAS float*)(lds + wave * 16384);
        const int gw = blockIdx.x * NWAVES + wave, NGW = gridDim.x * NWAVES;
        constexpr int I_AIN = 16 * 192, I_AOUT = 32 * 32, I_BIN = 16 * 80, I_BOUT = 16 * 32, I_PER = I_AIN + I_AOUT + I_BIN + I_BOUT;
        for (int it = gw; it < 2 * I_PER; it += NGW) {
            const int j = it / I_PER; int r = it % I_PER;
            unsigned char* wa = ws + WS_WA0 + (size_t)j * WA_SIZE; unsigned char* wb = ws + WS_WB0 + (size_t)j * WB_SIZE;
            if (r < I_AIN) { const int kb = r / 192, nb = r % 192, n0 = nb * 32; bf16_t* dst;
                if (n0 < 2048) dst = (bf16_t*)(wa + WA_UZ) + (size_t)(256 * (n0 >> 7) + (n0 & 127)) * 1024;
                else if (n0 < 4096) dst = (bf16_t*)(wa + WA_V) + (size_t)(n0 - 2048) * 1024;
                else { const int n1 = n0 - 4096; dst = (bf16_t*)(wa + WA_UZ) + (size_t)(256 * (n1 >> 7) + 128 + (n1 & 127)) * 1024; }
                transpose_item(P.a_w_in + (size_t)j * 1024 * 6144, 6144, 1024, dst, kb * 64, n0, scr, lane); continue; }
            r -= I_AIN;
            if (r < I_AOUT) { const int kb = r / 32, nb = r % 32, n0 = nb * 32;
                transpose_item(P.a_w_out + (size_t)j * 2048 * 1024, 1024, 2048, (bf16_t*)(wa + WA_OUT) + (size_t)n0 * 2048, kb * 64, n0, scr, lane); continue; }
            r -= I_AOUT;
            if (r < I_BIN) { const int kb = r / 80, nb = r % 80, n0 = nb * 32; bf16_t* dst;
                if (n0 < 1280) dst = (bf16_t*)(wb + WB_QKZ) + (size_t)n0 * 1024;
                else if (n0 < 1536) dst = (bf16_t*)(wb + WB_V) + (size_t)(n0 - 1280) * 1024;
                else dst = (bf16_t*)(wb + WB_QKZ) + (size_t)(n0 - 256) * 1024;
                transpose_item(P.b_w_in + (size_t)j * 1024 * 2560, 2560, 1024, dst, kb * 64, n0, scr, lane); continue; }
            r -= I_BIN;
            { const int kb = r / 32, nb = r % 32, n0 = nb * 32;
                transpose_item(P.b_w_out + (size_t)j * 1024 * 1024, 1024, 1024, (bf16_t*)(wb + WB_OUT) + (size_t)n0 * 1024, kb * 64, n0, scr, lane); }
        }
        const int gt = blockIdx.x * NTHREADS + tid, NGT = gridDim.x * NTHREADS;
        for (int i = gt; i < 2 * 8 * 128 * 128 / 8; i += NGT) { const int j = i >> 14, e = (i & 16383) * 8;
            const f32x4 v0 = *(const f32x4*)(P.a_w_s + (size_t)j * 131072 + e), v1 = *(const f32x4*)(P.a_w_s + (size_t)j * 131072 + e + 4);
            u32x4 w; w.x = cvtpk(v0[0], v0[1]); w.y = cvtpk(v0[2], v0[3]); w.z = cvtpk(v1[0], v1[1]); w.w = cvtpk(v1[2], v1[3]);
            *(u32x4*)((bf16_t*)(ws + WS_WA0 + (size_t)j * WA_SIZE + WA_S) + e) = w; }
    }
}

DI void p0b_h0(const Params& P) {
    const int tid = opaque_tid(), lane = tid & 63, wave = __builtin_amdgcn_readfirstlane(tid >> 6);
    const int gw = blockIdx.x * NWAVES + wave, NGW = gridDim.x * NWAVES;
    const float* mod = (const float*)(P.ws + WS_MOD);
    bf16_t* H = (bf16_t*)(P.ws + WS_H);
    for (int row = 2 * gw; row < T; row += 2 * NGW) {
        const float* xr = row < TL ? P.x + (size_t)row * DM : P.ctx + (size_t)(row - TL) * DM;
        const float* mr = mod + (row < TL ? (row >> 12) : 4) * 3072;
        f32x4 v[2][4], sh[4], sc[4];
#pragma unroll
        for (int q = 0; q < 2; ++q)
#pragma unroll
            for (int j = 0; j < 4; ++j) v[q][j] = __builtin_nontemporal_load((const f32x4*)(xr + q * DM + 4 * lane + 256 * j));
#pragma unroll
        for (int j = 0; j < 4; ++j) { const int c = 4 * lane + 256 * j; sh[j] = *(const f32x4*)(mr + c); sc[j] = *(const f32x4*)(mr + 1024 + c) + 1.0f; }
#pragma unroll
        for (int q = 0; q < 2; ++q)
#pragma unroll
            for (int j = 0; j < 4; ++j) { const int c = 4 * lane + 256 * j;
                const f32x4 h = v[q][j] * sc[j] + sh[j];
                u32x2 w; w.x = cvtpk(h[0], h[1]); w.y = cvtpk(h[2], h[3]);
                *(u32x2*)(H + (size_t)(row + q) * DM + c) = w; }
    }
}

DI void ln_phase(const Params& P, int layer) {
    const int tid = opaque_tid(), lane = tid & 63, wave = __builtin_amdgcn_readfirstlane(tid >> 6);
    const int gw = blockIdx.x * NWAVES + wave, NGW = gridDim.x * NWAVES;
    const bool last = layer == 3;
    const float* modn = (const float*)(P.ws + WS_MOD) + (layer + 1) * 15360;
    const float* lg = P.ln_g + layer * DM; const float* lb = P.ln_b + layer * DM;
    bf16_t* H = (bf16_t*)(P.ws + WS_H);
    const unsigned short* rl = last ? (const unsigned short*)(P.ws + WS_H) : (const unsigned short*)P.out;
    const unsigned short* rc = (const unsigned short*)(P.ws + WS_XC);
    float* rstat = (float*)(P.ws + WS_RSTAT);
    const int nrows = last ? TL : T;
    f32x4 g_[4], b_[4];
#pragma unroll
    for (int j = 0; j < 2; ++j) { const int c = 8 * lane + 512 * j; g_[2 * j] = *(const f32x4*)(lg + c); g_[2 * j + 1] = *(const f32x4*)(lg + c + 4); b_[2 * j] = *(const f32x4*)(lb + c); b_[2 * j + 1] = *(const f32x4*)(lb + c + 4); }
    for (int row = 2 * gw; row < nrows; row += 2 * NGW) {
        const unsigned short* xr = row < TL ? rl + (size_t)row * DM : rc + (size_t)(row - TL) * DM;
        const float* mr = modn + (row < TL ? (row >> 12) : 4) * 3072;
        u32x4 rv[2][2];
#pragma unroll
        for (int q = 0; q < 2; ++q)
#pragma unroll
            for (int j = 0; j < 2; ++j) rv[q][j] = *(const u32x4*)(xr + q * DM + 8 * lane + 512 * j);
        f32x4 G2_[4], B2_[4];
        if (!last) {
#pragma unroll
            for (int j = 0; j < 2; ++j) { const int c = 8 * lane + 512 * j;
                const f32x4 sca = *(const f32x4*)(mr + 1024 + c) + 1.0f, scb = *(const f32x4*)(mr + 1024 + c + 4) + 1.0f, sha = *(const f32x4*)(mr + c), shb = *(const f32x4*)(mr + c + 4);
                G2_[2 * j] = g_[2 * j] * sca; G2_[2 * j + 1] = g_[2 * j + 1] * scb; B2_[2 * j] = b_[2 * j] * sca + sha; B2_[2 * j + 1] = b_[2 * j + 1] * scb + shb; }
        } else {
#pragma unroll
            for (int i = 0; i < 4; ++i) { G2_[i] = g_[i]; B2_[i] = b_[i]; }
        }
        f32x4 v[2][4]; float s[2] = {0.f, 0.f};
#pragma unroll
        for (int q = 0; q < 2; ++q)
#pragma unroll
            for (int j = 0; j < 2; ++j) { const u32x4 t = rv[q][j];
                v[q][2 * j] = (f32x4){hlo(t.x), hhi(t.x), hlo(t.y), hhi(t.y)}; v[q][2 * j + 1] = (f32x4){hlo(t.z), hhi(t.z), hlo(t.w), hhi(t.w)}; }
#pragma unroll
        for (int q = 0; q < 2; ++q)
#pragma unroll
            for (int j = 0; j < 4; ++j) s[q] += (v[q][j][0] + v[q][j][1]) + (v[q][j][2] + v[q][j][3]);
#pragma unroll
        for (int q = 0; q < 2; ++q) s[q] = wave_sum_dpp(s[q]);
        float mean[2], s2[2] = {0.f, 0.f};
#pragma unroll
        for (int q = 0; q < 2; ++q) { mean[q] = s[q] * (1.f / DM);
#pragma unroll
            for (int j = 0; j < 4; ++j) { v[q][j] = v[q][j] - mean[q]; s2[q] += (v[q][j][0] * v[q][j][0] + v[q][j][1] * v[q][j][1]) + (v[q][j][2] * v[q][j][2] + v[q][j][3] * v[q][j][3]); } }
#pragma unroll
        for (int q = 0; q < 2; ++q) s2[q] = wave_sum_dpp(s2[q]);
#pragma unroll
        for (int q = 0; q < 2; ++q) {
            const float rstd = 1.0f / sqrtf(s2[q] * (1.f / DM) + LN_EPS);
#pragma unroll
            for (int j = 0; j < 2; ++j) { const int c = 8 * lane + 512 * j;
                const f32x4 ya = v[q][2 * j] * rstd * G2_[2 * j] + B2_[2 * j], yb = v[q][2 * j + 1] * rstd * G2_[2 * j + 1] + B2_[2 * j + 1];
                if (last) { float* op = P.out + (size_t)(row + q) * DM + c; __builtin_nontemporal_store(ya, (f32x4*)op); __builtin_nontemporal_store(yb, (f32x4*)(op + 4)); }
                else { u32x4 w; w.x = cvtpk(ya[0], ya[1]); w.y = cvtpk(ya[2], ya[3]); w.z = cvtpk(yb[0], yb[1]); w.w = cvtpk(yb[2], yb[3]);
                    *(u32x4*)(H + (size_t)(row + q) * DM + c) = w; }
            }
            if (!last && lane == 0) *(f32x2*)(rstat + (size_t)(row + q) * 2) = (f32x2){mean[q], rstd};
        }
    }
}

DI void spatial_mix(const Params& P, int j, LAS unsigned char* lds) {
    const int tid = opaque_tid(), lane = tid & 63, wave = __builtin_amdgcn_readfirstlane(tid >> 6);
    const bf16_t* Wsb = (const bf16_t*)(P.ws + WS_WA0 + (size_t)j * WA_SIZE + WA_S);
    const float* bs = P.a_b_s + j * 1024; const float* lng = P.a_ln_g + j * AW; const float* lnb = P.a_ln_b + j * AW;
    const bf16_t* VT = (const bf16_t*)(P.ws + WS_ACT + ACT_VTA); bf16_t* UZ = (bf16_t*)(P.ws + WS_ACT + ACT_UZ);
    const float* stat = (const float*)(P.ws + WS_STAT);
    LAS unsigned char* Wl = lds;
    LAS float* smu = (LAS float*)(lds + 36864);
    const int r16 = lane & 15, kq = lane >> 4;
    const bool hoist = (gridDim.x & 7) == 0 && gridDim.x * 8 >= 136 * 8;
    if (hoist) {
        const int g = blockIdx.x & 7;
#pragma unroll
        for (int i = 0; i < 4; ++i) { const int piece = tid + NTHREADS * i, row = piece >> 4, cp = piece & 15;
            *(LAS u32x4*)(Wl + row * 272 + cp * 16) = *(const u32x4*)(Wsb + (size_t)g * 16384 + row * 128 + cp * 8); }
        for (int t = tid; t < 8 * 128; t += NTHREADS) { const int it = t >> 7, item = blockIdx.x + it * gridDim.x;
            if (item < 136 * 8) { const float* sp = stat + (size_t)((item >> 3) * 128 + (t & 127)) * 32; float a = 0.f, b = 0.f;
#pragma unroll
                for (int q8 = 0; q8 < 8; ++q8) { const f32x4 q = *(const f32x4*)(sp + 4 * q8); a += q[0] + q[2]; b += q[1] + q[3]; }
                const float mu = a * (1.f / AW); const float var = fmaxf(b * (1.f / AW) - mu * mu, 0.f);
                smu[it * 256 + (t & 127)] = mu; smu[it * 256 + 128 + (t & 127)] = 1.0f / sqrtf(var + LN_EPS); } }
        __syncthreads();
    }
    int itn = 0;
    for (int item = blockIdx.x; item < 136 * 8; item += gridDim.x, ++itn) {
        const int chunk = item >> 3, g = item & 7;
        if (!hoist) {
        __syncthreads();
        if (tid < 128) { const float* sp = stat + (size_t)(chunk * 128 + tid) * 32; float a = 0.f, b = 0.f;
#pragma unroll
            for (int s = 0; s < 8; ++s) { const f32x4 q = *(const f32x4*)(sp + 4 * s); a += q[0] + q[2]; b += q[1] + q[3]; }
            const float mu = a * (1.f / AW); const float var = fmaxf(b * (1.f / AW) - mu * mu, 0.f);
            smu[tid] = mu; smu[128 + tid] = 1.0f / sqrtf(var + LN_EPS); }
#pragma unroll
        for (int i = 0; i < 4; ++i) { const int piece = tid + NTHREADS * i, row = piece >> 4, cp = piece & 15;
            *(LAS u32x4*)(Wl + row * 272 + cp * 16) = *(const u32x4*)(Wsb + (size_t)g * 16384 + row * 128 + cp * 8); }
        __syncthreads();
        }
        const LAS float* smu_i = smu + (hoist ? itn * 256 : 0); const LAS float* srs_i = smu_i + 128;
        const int cw = g * 256 + 32 * wave;
        u32x4 gvr[2][4]; float ga[2], be[2];
#pragma unroll
        for (int ct = 0; ct < 2; ++ct) { const int ch = cw + 16 * ct + r16; ga[ct] = lng[ch]; be[ct] = lnb[ch];
#pragma unroll
            for (int ks = 0; ks < 4; ++ks) gvr[ct][ks] = *(const u32x4*)(VT + (size_t)ch * T + chunk * 128 + 32 * ks + 8 * kq); }
        u32x2 uzr[8][2];
        float bsr[8];
#pragma unroll
        for (int pt = 0; pt < 8; ++pt) bsr[pt] = bs[g * 128 + 16 * pt + r16];
        __builtin_amdgcn_sched_barrier(0);
#pragma unroll
        for (int pt = 0; pt < 8; ++pt)
#pragma unroll
            for (int ct = 0; ct < 2; ++ct) uzr[pt][ct] = *(const u32x2*)(UZ + (size_t)(chunk * 128 + 16 * pt + r16) * AW + cw + 16 * ct + 4 * kq);
        f32x4 acc[2][8];
#pragma unroll
        for (int ct = 0; ct < 2; ++ct)
#pragma unroll
            for (int pt = 0; pt < 8; ++pt) acc[ct][pt] = (f32x4){0.f, 0.f, 0.f, 0.f};
#pragma unroll
        for (int ks = 0; ks < 4; ++ks) {
            const f32x4 m0 = *(const LAS f32x4*)(smu_i + 32 * ks + 8 * kq), m1 = *(const LAS f32x4*)(smu_i + 32 * ks + 8 * kq + 4);
            const f32x4 r0 = *(const LAS f32x4*)(srs_i + 32 * ks + 8 * kq), r1 = *(const LAS f32x4*)(srs_i + 32 * ks + 8 * kq + 4);
            bf16x8 af[2];
#pragma unroll
            for (int ct = 0; ct < 2; ++ct) { const u32x4 gq = gvr[ct][ks];
                u32x4 w;
                w.x = cvtpk((bflo(gq.x) - m0[0]) * r0[0] * ga[ct] + be[ct], (bfhi(gq.x) - m0[1]) * r0[1] * ga[ct] + be[ct]);
                w.y = cvtpk((bflo(gq.y) - m0[2]) * r0[2] * ga[ct] + be[ct], (bfhi(gq.y) - m0[3]) * r0[3] * ga[ct] + be[ct]);
                w.z = cvtpk((bflo(gq.z) - m1[0]) * r1[0] * ga[ct] + be[ct], (bfhi(gq.z) - m1[1]) * r1[1] * ga[ct] + be[ct]);
                w.w = cvtpk((bflo(gq.w) - m1[2]) * r1[2] * ga[ct] + be[ct], (bfhi(gq.w) - m1[3]) * r1[3] * ga[ct] + be[ct]);
                af[ct] = __builtin_bit_cast(bf16x8, w); }
#pragma unroll
            for (int pt = 0; pt < 8; ++pt) { const bf16x8 bfr = *(const LAS bf16x8*)(Wl + (16 * pt + r16) * 272 + (32 * ks + 8 * kq) * 2);
                acc[0][pt] = __builtin_amdgcn_mfma_f32_16x16x32_bf16(af[0], bfr, acc[0][pt], 0, 0, 0);
                acc[1][pt] = __builtin_amdgcn_mfma_f32_16x16x32_bf16(af[1], bfr, acc[1][pt], 0, 0, 0); }
        }
#pragma unroll
        for (int pt = 0; pt < 8; ++pt) { const int p = 16 * pt + r16; const float bsv = bsr[pt];
#pragma unroll
            for (int ct = 0; ct < 2; ++ct) { bf16_t* up = UZ + (size_t)(chunk * 128 + p) * AW + cw + 16 * ct + 4 * kq;
                const u32x2 uz = uzr[pt][ct]; const f32x4 a = acc[ct][pt];
                u32x2 w; w.x = cvtpk(bflo(uz.x) * (a[0] + bsv), bfhi(uz.x) * (a[1] + bsv)); w.y = cvtpk(bflo(uz.y) * (a[2] + bsv), bfhi(uz.y) * (a[3] + bsv));
                *(u32x2*)up = w; } }
    }
}

DI void attn_phase(const Params& P, int j, bool ctxq, LAS unsigned char* lds) {
    const int tid = opaque_tid(), lane = tid & 63, wave = __builtin_amdgcn_readfirstlane(tid >> 6);
    const bf16_t* Q = (const bf16_t*)(P.ws + WS_ACT + ACT_Q); const bf16_t* Kb = (const bf16_t*)(P.ws + WS_ACT + ACT_K);
    const bf16_t* VT = (const bf16_t*)(P.ws + WS_ACT + ACT_VTB); const bf16_t* Z = (const bf16_t*)(P.ws + WS_ACT + ACT_Z); bf16_t* OZ = (bf16_t*)(P.ws + WS_ACT + ACT_OZ);
    const float* sink = P.b_sink + j * 16;
    const int r = lane & 31, h = lane >> 5;
    const int nitems = 1024 + (ctxq ? 64 : 0);
    const int g = wave >> 1, sub = wave & 1;
    constexpr int KP = 144, VP = 136, VOFF = 64 * KP, BUFB = VOFF + 64 * VP;
    const int lrow = tid >> 3, lpc = tid & 7;
    const int kw_off = lrow * KP + lpc * 16, vw_off = VOFF + lrow * VP + lpc * 16;
    const int kfo = r * KP + 16 * h, vfo = VOFF + r * VP + 8 * h;
    const int vcu = (gridDim.x % 8 == 0) ? (int)((blockIdx.x % 8) * (gridDim.x / 8) + blockIdx.x / 8) : (int)blockIdx.x;
    for (int bi = vcu; bi < nitems; bi += gridDim.x) {
        int b, kvh, qrow0, jt_lo, nband, bandrow0, ctxrow0;
        if (bi < 1024) { b = bi >> 8; kvh = (bi >> 6) & 3; const int q64 = bi & 63, qbase = 64 * q64; qrow0 = b * SEQ + qbase + 32 * sub;
            jt_lo = (4 - 2 * q64) > 0 ? (4 - 2 * q64) : 0; const int jt_hi = (131 - 2 * q64) < 9 ? (131 - 2 * q64) : 9; nband = jt_hi - jt_lo + 1; bandrow0 = b * SEQ + qbase - 128; }
        else { const int ci = bi - 1024; b = ci >> 4; kvh = (ci >> 2) & 3; qrow0 = TL + b * CL + 64 * (ci & 3) + 32 * sub; jt_lo = 0; nband = 0; bandrow0 = 0; }
        ctxrow0 = TL + b * CL;
        const int NT = nband + 8, NS = (NT + 1) >> 1;
        const int head = kvh * 4 + g;
        const bf16_t* ksrc = Kb + (size_t)(lrow & 31) * 256 + kvh * 64 + lpc * 8;
        const bf16_t* vsrc = VT + (size_t)(kvh * 64 + lrow) * T + (lpc & 3) * 8;
#define ATT_KROW(i) ((i) < nband ? (bandrow0 + 32 * (jt_lo + (i))) : (ctxrow0 + 32 * ((i) - nband)))
#define ATT_TIDX(st, w) ((2 * (st) + (w)) < NT ? (2 * (st) + (w)) : (NT - 1))
#define ATT_GLOADK(st) (*(const u32x4*)(ksrc + (size_t)ATT_KROW(ATT_TIDX(st, lrow >> 5)) * 256))
#define ATT_GLOADV(st) (*(const u32x4*)(vsrc + (size_t)ATT_KROW(ATT_TIDX(st, lpc >> 2))))
#define ATT_LWRITE(bufi, kv, vv) do { LAS unsigned char* _p = lds + (bufi) * BUFB; *(LAS u32x4*)(_p + kw_off) = (kv); \
            *(LAS u32x2*)(_p + vw_off) = (u32x2){(vv).x, (vv).y}; *(LAS u32x2*)(_p + vw_off + 8) = (u32x2){(vv).z, (vv).w}; } while (0)
        bf16x8 qf[4];
#pragma unroll
        for (int s = 0; s < 4; ++s) qf[s] = *(const bf16x8*)(Q + (size_t)(qrow0 + r) * 1024 + head * 64 + 16 * s + 8 * h);
        const size_t obase = (size_t)(qrow0 + r) * 1024 + head * 64 + 4 * h;
        u32x2 zr[2][4];
#pragma unroll
        for (int g4 = 0; g4 < 4; ++g4) { zr[0][g4] = *(const u32x2*)(Z + obase + 8 * g4); zr[1][g4] = *(const u32x2*)(Z + obase + 32 + 8 * g4); }
        float m_run = sink[head] * LOG2E; float l_part = (h == 0) ? 1.f : 0.f;
        f32x16 o0, o1;
#pragma unroll
        for (int i = 0; i < 16; ++i) { o0[i] = 0.f; o1[i] = 0.f; }
        __syncthreads();
        u32x4 rk[2], rv[2];
        rk[0] = ATT_GLOADK(0); rv[0] = ATT_GLOADV(0); rk[1] = ATT_GLOADK(1); rv[1] = ATT_GLOADV(1);
        ATT_LWRITE(0, rk[0], rv[0]);
        __syncthreads();
        for (int st0 = 0; st0 < NS; st0 += 2) {
#pragma unroll
            for (int u2 = 0; u2 < 2; ++u2) {
                const int st = st0 + u2;
                if (st < NS) {
                    rk[u2] = ATT_GLOADK(st + 2); rv[u2] = ATT_GLOADV(st + 2);
                    const LAS unsigned char* bp = lds + (st & 1) * BUFB;
                    int mode[2];
#pragma unroll
                    for (int w = 0; w < 2; ++w) { const int i = 2 * st + w; const int t = jt_lo + i - sub;
                        mode[w] = (i >= NT) ? 3 : ((i >= nband) ? 0 : ((t < 0 || t > 8) ? 3 : (t == 0 ? 1 : (t == 8 ? 2 : 0)))); }
                    const int mA = __builtin_amdgcn_readfirstlane(mode[0]), mB = __builtin_amdgcn_readfirstlane(mode[1]);
                    if ((mA | mB) != 0) {
                        asm volatile("" ::: "memory");
                    f32x16 S[2];
#pragma unroll
                        for (int w = 0; w < 2; ++w)
#pragma unroll
                            for (int q = 0; q < 16; ++q) S[w][q] = 0.f;
#pragma unroll
                        for (int s = 0; s < 4; ++s) {
                            const bf16x8 ka = *(const LAS bf16x8*)(bp + kfo + 32 * s), kb = *(const LAS bf16x8*)(bp + kfo + 32 * KP + 32 * s);
                            S[0] = __builtin_amdgcn_mfma_f32_32x32x16_bf16(ka, qf[s], S[0], 0, 0, 0); S[1] = __builtin_amdgcn_mfma_f32_32x32x16_bf16(kb, qf[s], S[1], 0, 0, 0); }
                        {
                        const int rr = r - 4 * h;
#pragma unroll
                        for (int w = 0; w < 2; ++w) { const int mw = w ? mB : mA;
                            if (mw == 1) {
#pragma unroll
                                for (int q = 0; q < 16; ++q) { const int c = (q & 3) + 8 * (q >> 2); S[w][q] = (c >= rr) ? S[w][q] : -1e30f; } }
                            else if (mw == 2) {
#pragma unroll
                                for (int q = 0; q < 16; ++q) { const int c = (q & 3) + 8 * (q >> 2); S[w][q] = (c <= rr) ? S[w][q] : -1e30f; } }
                            else if (mw == 3) {
#pragma unroll
                                for (int q = 0; q < 16; ++q) S[w][q] = -1e30f; } }
                        }
                    float mx = max3f(S[0][0], S[1][0], m_run);
#pragma unroll
                        for (int q = 1; q < 16; ++q) mx = max3f(mx, S[0][q], S[1][q]);
                        mx = fmaxf(mx, xhalf_f(mx));
                        if (__builtin_amdgcn_ballot_w64(mx - m_run > 8.0f) != 0ull) { const float alpha = __builtin_amdgcn_exp2f(m_run - mx); l_part *= alpha; m_run = mx;
#pragma unroll
                            for (int q = 0; q < 16; ++q) { o0[q] *= alpha; o1[q] *= alpha; } }
                        f32x2 ps2 = {0.f, 0.f}; const f32x2 mn2 = {m_run, m_run};
#pragma unroll
                        for (int w = 0; w < 2; ++w)
#pragma unroll
                            for (int q = 0; q < 16; q += 2) { const f32x2 d = (f32x2){S[w][q], S[w][q + 1]} - mn2;
                                const f32x2 e = {__builtin_amdgcn_exp2f(d.x), __builtin_amdgcn_exp2f(d.y)}; S[w][q] = e.x; S[w][q + 1] = e.y; ps2 += e; }
                        const float psum = ps2.x + ps2.y;
                        l_part += psum;
#pragma unroll
                        for (int w = 0; w < 2; ++w)
#pragma unroll
                            for (int s = 0; s < 2; ++s) { u32x4 pw; pw.x = cvtpk(S[w][8 * s], S[w][8 * s + 1]); pw.y = cvtpk(S[w][8 * s + 2], S[w][8 * s + 3]); pw.z = cvtpk(S[w][8 * s + 4], S[w][8 * s + 5]); pw.w = cvtpk(S[w][8 * s + 6], S[w][8 * s + 7]);
                                const bf16x8 pf = __builtin_bit_cast(bf16x8, pw);
                                const int vo = vfo + 64 * w + 32 * s;
                                const u32x2 a0 = *(const LAS u32x2*)(bp + vo), a1 = *(const LAS u32x2*)(bp + vo + 16);
                                const u32x2 c0 = *(const LAS u32x2*)(bp + vo + 32 * VP), c1 = *(const LAS u32x2*)(bp + vo + 32 * VP + 16);
                                const bf16x8 va = __builtin_bit_cast(bf16x8, (u32x4){a0.x, a0.y, a1.x, a1.y}), vb = __builtin_bit_cast(bf16x8, (u32x4){c0.x, c0.y, c1.x, c1.y});
                                o0 = __builtin_amdgcn_mfma_f32_32x32x16_bf16(va, pf, o0, 0, 0, 0); o1 = __builtin_amdgcn_mfma_f32_32x32x16_bf16(vb, pf, o1, 0, 0, 0); }
                    } else {
                    f32x16 S[2];
#pragma unroll
                        for (int w = 0; w < 2; ++w)
#pragma unroll
                            for (int q = 0; q < 16; ++q) S[w][q] = 0.f;
#pragma unroll
                        for (int s = 0; s < 4; ++s) {
                            const bf16x8 ka = *(const LAS bf16x8*)(bp + kfo + 32 * s), kb = *(const LAS bf16x8*)(bp + kfo + 32 * KP + 32 * s);
                            S[0] = __builtin_amdgcn_mfma_f32_32x32x16_bf16(ka, qf[s], S[0], 0, 0, 0); S[1] = __builtin_amdgcn_mfma_f32_32x32x16_bf16(kb, qf[s], S[1], 0, 0, 0); }
                    float mx = max3f(S[0][0], S[1][0], m_run);
#pragma unroll
                        for (int q = 1; q < 16; ++q) mx = max3f(mx, S[0][q], S[1][q]);
                        mx = fmaxf(mx, xhalf_f(mx));
                        if (__builtin_amdgcn_ballot_w64(mx - m_run > 8.0f) != 0ull) { const float alpha = __builtin_amdgcn_exp2f(m_run - mx); l_part *= alpha; m_run = mx;
#pragma unroll
                            for (int q = 0; q < 16; ++q) { o0[q] *= alpha; o1[q] *= alpha; } }
                        f32x2 ps2 = {0.f, 0.f}; const f32x2 mn2 = {m_run, m_run};
#pragma unroll
                        for (int w = 0; w < 2; ++w)
#pragma unroll
                            for (int q = 0; q < 16; q += 2) { const f32x2 d = (f32x2){S[w][q], S[w][q + 1]} - mn2;
                                const f32x2 e = {__builtin_amdgcn_exp2f(d.x), __builtin_amdgcn_exp2f(d.y)}; S[w][q] = e.x; S[w][q + 1] = e.y; ps2 += e; }
                        const float psum = ps2.x + ps2.y;
                        l_part += psum;
#pragma unroll
                        for (int w = 0; w < 2; ++w)
#pragma unroll
                            for (int s = 0; s < 2; ++s) { u32x4 pw; pw.x = cvtpk(S[w][8 * s], S[w][8 * s + 1]); pw.y = cvtpk(S[w][8 * s + 2], S[w][8 * s + 3]); pw.z = cvtpk(S[w][8 * s + 4], S[w][8 * s + 5]); pw.w = cvtpk(S[w][8 * s + 6], S[w][8 * s + 7]);
                                const bf16x8 pf = __builtin_bit_cast(bf16x8, pw);
                                const int vo = vfo + 64 * w + 32 * s;
                                const u32x2 a0 = *(const LAS u32x2*)(bp + vo), a1 = *(const LAS u32x2*)(bp + vo + 16);
                                const u32x2 c0 = *(const LAS u32x2*)(bp + vo + 32 * VP), c1 = *(const LAS u32x2*)(bp + vo + 32 * VP + 16);
                                const bf16x8 va = __builtin_bit_cast(bf16x8, (u32x4){a0.x, a0.y, a1.x, a1.y}), vb = __builtin_bit_cast(bf16x8, (u32x4){c0.x, c0.y, c1.x, c1.y});
                                o0 = __builtin_amdgcn_mfma_f32_32x32x16_bf16(va, pf, o0, 0, 0, 0); o1 = __builtin_amdgcn_mfma_f32_32x32x16_bf16(vb, pf, o1, 0, 0, 0); }
                    }
                    ATT_LWRITE((st + 1) & 1, rk[u2 ^ 1], rv[u2 ^ 1]);
                    __syncthreads();
                }
            }
        }
#undef ATT_KROW
#undef ATT_TIDX
#undef ATT_GLOADK
#undef ATT_GLOADV
#undef ATT_LWRITE
        const float l = l_part + __shfl_xor(l_part, 32); const float inv = 1.0f / l;
#pragma unroll
        for (int g4 = 0; g4 < 4; ++g4) {
            { const u32x2 z = zr[0][g4]; u32x2 w;
              w.x = cvtpk(o0[4 * g4] * inv * bflo(z.x), o0[4 * g4 + 1] * inv * bfhi(z.x)); w.y = cvtpk(o0[4 * g4 + 2] * inv * bflo(z.y), o0[4 * g4 + 3] * inv * bfhi(z.y));
              *(u32x2*)(OZ + obase + 8 * g4) = w; }
            { const u32x2 z = zr[1][g4]; u32x2 w;
              w.x = cvtpk(o1[4 * g4] * inv * bflo(z.x), o1[4 * g4 + 1] * inv * bfhi(z.x)); w.y = cvtpk(o1[4 * g4 + 2] * inv * bflo(z.y), o1[4 * g4 + 3] * inv * bfhi(z.y));
              *(u32x2*)(OZ + obase + 32 + 8 * g4) = w; }
        }
    }
}

#define XB_TMO      128
#define XB_XCNT(j)  (256  + 64 * (j))
#define XB_XSUB(j)  (1280 + 64 * (j))
#define XB_XGEN(j)  (2304 + 64 * (j))
#define XB_TOP      3328
#define XB_TOPGEN   3392
#define XCD_BAR_WORDS 3456
#define XB_SPIN_CAP (1u << 18)
DI unsigned xb_ld(unsigned* p)              { return __hip_atomic_load(p, __ATOMIC_RELAXED, __HIP_MEMORY_SCOPE_AGENT); }
DI unsigned xb_add(unsigned* p, unsigned v) { return __hip_atomic_fetch_add(p, v, __ATOMIC_RELAXED, __HIP_MEMORY_SCOPE_AGENT); }
DI unsigned xb_xcc_id() { return (unsigned)__builtin_amdgcn_s_getreg((3 << 11) | 20) & 0xFu; }
#define XB_SPIN(cond, bar) do { unsigned _sp = 0; while (cond) { __builtin_amdgcn_s_sleep(1); \
    if ((++_sp & 255u) == 0u) { if (xb_ld(&(bar)[XB_TMO])) break; if (_sp > XB_SPIN_CAP) { atomicAdd(&(bar)[XB_TMO], 1u); break; } } } } while (0)
struct XcdBarrier { unsigned* bar; unsigned x; volatile LAS unsigned* st; };
DI XcdBarrier xcd_barrier_post(unsigned* bar, volatile LAS unsigned* st) {
    XcdBarrier b; b.bar = bar; b.x = xb_xcc_id(); b.st = st;
    if (threadIdx.x == 0) (void)xb_add(&bar[XB_XCNT(b.x)], 1u);
    return b;
}
DI void xcd_barrier_census_wave(unsigned* bar, unsigned x, volatile LAS unsigned* st) {
    const unsigned G = gridDim.x * gridDim.y * gridDim.z;
    const unsigned lane = threadIdx.x & 63u;
    unsigned c, sum, sp = 0u;
    for (;;) {
        c = lane < 16u ? xb_ld(&bar[XB_XCNT(lane)]) : 0u;
        sum = c;
#pragma unroll
        for (int o = 1; o < 64; o <<= 1) sum += (unsigned)__shfl_xor((int)sum, o);
        if (sum == G) break;
        __builtin_amdgcn_s_sleep(1);
        if ((++sp & 255u) == 0u) { if (xb_ld(&bar[XB_TMO])) break; if (sp > XB_SPIN_CAP) { if (lane == 0u) atomicAdd(&bar[XB_TMO], 1u); break; } }
    }
    const unsigned cnt = (unsigned)__popcll(__builtin_amdgcn_ballot_w64(c > 0u));
    const unsigned mine = (unsigned)__shfl((int)c, (int)x);
    if (lane == 0u) { st[0] = mine > 0u ? mine : 1u; st[1] = cnt > 0u ? cnt : 1u; }
}
DI void xcd_barrier(const XcdBarrier& b) {
    asm volatile("s_waitcnt vmcnt(0)" ::: "memory");
    __syncthreads();
    if (threadIdx.x == 0) {
        unsigned* bar = b.bar;
        __builtin_amdgcn_s_waitcnt(0);
        const unsigned nloc = b.st[0], nx = b.st[1];
        const unsigned old = xb_add(&bar[XB_XSUB(b.x)], 1u);
        const unsigned gen = old / nloc;
        if (old + 1u == (gen + 1u) * nloc) {
            __builtin_amdgcn_fence(__ATOMIC_RELEASE, "agent");
            asm volatile("s_waitcnt vmcnt(0)" ::: "memory");
            const unsigned og = xb_add(&bar[XB_TOP], 1u);
            const unsigned tg = og / nx;
            if (og + 1u == (tg + 1u) * nx) xb_add(&bar[XB_TOPGEN], 1u);
            else XB_SPIN(xb_ld(&bar[XB_TOPGEN]) == tg, bar);
            __builtin_amdgcn_fence(__ATOMIC_ACQUIRE, "agent");
            xb_add(&bar[XB_XGEN(b.x)], 1u);
            asm volatile("s_waitcnt vmcnt(0)" ::: "memory");
        } else {
            XB_SPIN(xb_ld(&bar[XB_XGEN(b.x)]) == gen, bar);
            __builtin_amdgcn_fence(__ATOMIC_ACQUIRE, "agent");
            asm volatile("s_waitcnt vmcnt(0)" ::: "memory");
        }
    }
    __syncthreads();
}

__global__ void __launch_bounds__(NTHREADS, 2) fwd_megakernel(Params P) {
    extern __shared__ __attribute__((aligned(16))) unsigned char lds_raw[];
    LAS unsigned char* lds = (LAS unsigned char*)lds_raw;
    { volatile LAS unsigned* st0 = (volatile LAS unsigned*)(lds + 143360); if (threadIdx.x < 2) st0[threadIdx.x] = 0u; }
    __syncthreads();
    (void)xcd_barrier_post((unsigned*)(P.ws + WS_BAR), (volatile LAS unsigned*)(lds + 143360));
#define GSYNC() do { XcdBarrier xb_; xb_.bar = (unsigned*)(P.ws + WS_BAR); xb_.x = xb_xcc_id(); xb_.st = (volatile LAS unsigned*)(lds + 143360); xcd_barrier(xb_); } while (0)
    unsigned char* ws = P.ws;
    const int G = gridDim.x, cid = blockIdx.x;

#ifndef SKIP_P0
    p0_prologue(P, lds);
#endif
    if (threadIdx.x < 64) xcd_barrier_census_wave((unsigned*)(P.ws + WS_BAR), xb_xcc_id(), (volatile LAS unsigned*)(lds + 143360));
    GSYNC();
#ifndef SKIP_P0B
    p0b_h0(P);
#endif
    GSYNC();

    const bf16_t* H = (const bf16_t*)(ws + WS_H);
    const float* mod = (const float*)(ws + WS_MOD);
#pragma nounroll
    for (int layer = 0; layer < 4; ++layer) {
        const int j = layer >> 1;
        EpiG2 E2; E2.x0 = layer == 0 ? P.x : nullptr; E2.rsrc = (const unsigned short*)P.out; E2.rdst = layer == 3 ? (unsigned short*)(ws + WS_H) : (unsigned short*)P.out;
        E2.xc0 = layer == 0 ? P.ctx : nullptr; E2.rc = (unsigned short*)(ws + WS_XC); E2.gate = mod + layer * 15360 + 2048;
        E2.rstat = (const float*)(ws + WS_RSTAT); E2.png = P.ln_g + (layer > 0 ? layer - 1 : 0) * DM; E2.pnb = P.ln_b + (layer > 0 ? layer - 1 : 0) * DM;
        const int nM2 = 64;
        if ((layer & 1) == 0) {
            unsigned char* wa = ws + WS_WA0 + (size_t)j * WA_SIZE;
            { pg8::VSched S; S.init(68, 24, 16, G, cid, H, wa + WA_UZ, wa + WA_V, 1024);
              EpiG1A E; E.UZ = (bf16_t*)(ws + WS_ACT + ACT_UZ); E.VT = (bf16_t*)(ws + WS_ACT + ACT_VTA); E.stat = (float*)(ws + WS_STAT);
#ifndef SKIP_G1A
              { int nrep = REPN_G1A; asm volatile("" : "+s"(nrep));
#pragma nounroll
                for (int rep = 0; rep < nrep; ++rep) pg8::gemm_phase<EpiG1A, true, true>(lds, 1024, S, E); }
#endif
            }
            GSYNC();
#ifndef SKIP_SM
            spatial_mix(P, j, lds);
#endif
            GSYNC();
            { pg8::VSched S; S.init(nM2, 4, 4, G, cid, ws + WS_ACT + ACT_UZ, wa + WA_OUT, nullptr, 2048);
#ifndef SKIP_G2
              pg8::gemm_phase<EpiG2, true, true>(lds, 2048, S, E2);
#endif
            }
            if (layer < 3) g2_ctx_small(P, lds, (const bf16_t*)(ws + WS_ACT + ACT_UZ) + (size_t)TL * 2048, (const bf16_t*)(wa + WA_OUT), 2048, E2);
            GSYNC();
        } else {
            unsigned char* wb = ws + WS_WB0 + (size_t)j * WB_SIZE;
            { pg8::VSched S; S.init(68, 10, 9, G, cid, H, wb + WB_QKZ, wb + WB_V, 1024);
              EpiG1B E; E.Q = (bf16_t*)(ws + WS_ACT + ACT_Q); E.Kb = (bf16_t*)(ws + WS_ACT + ACT_K); E.Z = (bf16_t*)(ws + WS_ACT + ACT_Z); E.VT = (bf16_t*)(ws + WS_ACT + ACT_VTB); E.rope = (const LAS float*)(lds + 131072);
              { const int ct = opaque_tid(); *(LAS u32x4*)(lds + 131072 + ct * 16) = *(const u32x4*)(ws + WS_ROPE + ct * 16); __syncthreads(); }
#ifndef SKIP_G1B
              { int nrep = REPN_G1B; asm volatile("" : "+s"(nrep));
#pragma nounroll
                for (int rep = 0; rep < nrep; ++rep) pg8::gemm_phase<EpiG1B, true, true>(lds, 1024, S, E); }
#endif
            }
            GSYNC();
#ifndef SKIP_ATT
            attn_phase(P, j, layer < 3, lds);
#ifdef REP_ATT
            attn_phase(P, j, layer < 3, lds);
#endif
#endif
            GSYNC();
            { pg8::VSched S; S.init(nM2, 4, 4, G, cid, ws + WS_ACT + ACT_OZ, wb + WB_OUT, nullptr, 1024);
#ifndef SKIP_G2
              pg8::gemm_phase<EpiG2, true, true>(lds, 1024, S, E2);
#endif
            }
            if (layer < 3) g2_ctx_small(P, lds, (const bf16_t*)(ws + WS_ACT + ACT_OZ) + (size_t)TL * 1024, (const bf16_t*)(wb + WB_OUT), 1024, E2);
            GSYNC();
        }
#ifndef SKIP_LN
        ln_phase(P, layer);
#endif
        if (layer < 3) GSYNC();
#ifdef REP_SYNC
        GSYNC(); GSYNC(); GSYNC(); GSYNC();
#endif
    }
}

extern "C" void kernel_launch(void* const* d_in, const int* in_sizes, int n_in, void* d_out, int out_size, void* d_ws, size_t ws_size, hipStream_t stream) {
    static int grid = 0;
    if (grid == 0) {
        if (n_in != 17 || out_size != TL * DM || ws_size < WS_END) { fprintf(stderr, "kernel_launch: unexpected shapes (n_in %d out %d ws %zu)\n", n_in, out_size, ws_size); grid = -1; return; }
        int dev = 0, cus = 0, per_cu = 0;
        hipGetDevice(&dev);
        hipDeviceGetAttribute(&cus, hipDeviceAttributeMultiprocessorCount, dev);
        hipFuncSetAttribute((const void*)fwd_megakernel, hipFuncAttributeMaxDynamicSharedMemorySize, LDS_BYTES);
        hipOccupancyMaxActiveBlocksPerMultiprocessor(&per_cu, (const void*)fwd_megakernel, NTHREADS, LDS_BYTES);
        if (per_cu < 1) { fprintf(stderr, "kernel_launch: occupancy query says %d blocks/CU\n", per_cu); per_cu = 1; }
        grid = cus * per_cu;
        fprintf(stderr, "kernel_launch: cus %d per_cu %d grid %d\n", cus, per_cu, grid);
    }
    if (grid < 0) return;
    Params p{};
    p.x = (const float*)d_in[0]; p.c = (const float*)d_in[1]; p.ctx = (const float*)d_in[2]; p.c_ctx = (const float*)d_in[3];
    p.ada_w = (const float*)d_in[4]; p.ada_b = (const float*)d_in[5]; p.ln_g = (const float*)d_in[6]; p.ln_b = (const float*)d_in[7];
    p.a_w_in = (const float*)d_in[8]; p.a_ln_g = (const float*)d_in[9]; p.a_ln_b = (const float*)d_in[10]; p.a_w_s = (const float*)d_in[11]; p.a_b_s = (const float*)d_in[12]; p.a_w_out = (const float*)d_in[13];
    p.b_w_in = (const float*)d_in[14]; p.b_sink = (const float*)d_in[15]; p.b_w_out = (const float*)d_in[16];
    p.out = (float*)d_out; p.ws = (unsigned char*)d_ws;
    (void)hipMemsetAsync((char*)d_ws + WS_BAR, 0, XCD_BAR_WORDS * 4, stream);
    void* args[] = {&p};
    hipError_t e = hipLaunchCooperativeKernel((const void*)fwd_megakernel, dim3(grid), dim3(NTHREADS), args, LDS_BYTES, stream);
    if (e != hipSuccess) fprintf(stderr, "cooperative launch failed: %s (grid %d)\n", hipGetErrorString(e), grid);
}
```

```cpp
#include <hip/hip_runtime.h>
#include <cstdio>
#include <cstdint>
#ifndef REPN_G1A
#define REPN_G1A 1
#endif
#ifndef REPN_G1B
#define REPN_G1B 1
#endif

#define LAS __attribute__((address_space(3)))
#define DI __device__ __forceinline__
typedef unsigned short bf16_t;
typedef short bf16x8 __attribute__((ext_vector_type(8)));
typedef short s16x4 __attribute__((ext_vector_type(4)));
typedef float f32x2 __attribute__((ext_vector_type(2)));
typedef float f32x4 __attribute__((ext_vector_type(4)));
typedef float f32x16 __attribute__((ext_vector_type(16)));
typedef unsigned u32x2 __attribute__((ext_vector_type(2)));
typedef unsigned u32x4 __attribute__((ext_vector_type(4)));
typedef __bf16 bf16x2_t __attribute__((ext_vector_type(2)));

constexpr int DM = 1024, NB = 4, SEQ = 4096, TL = NB * SEQ, CL = 256, TC = NB * CL, T = TL + TC;
constexpr int AW = 2048;
constexpr float LN_EPS = 1e-5f;
constexpr float ALPHA = 1.681792830507429f;
constexpr float LOG2E = 1.4426950408889634f;
constexpr int NTHREADS = 512, NWAVES = 8;
constexpr int LDS_BYTES = 147456;

constexpr size_t MiB = 1u << 20;
constexpr size_t WS_MOD = 0;
constexpr size_t WS_ROPE = 262144;
constexpr size_t WS_STAT = 524288;
constexpr size_t WS_BAR = 2883584;
constexpr size_t WS_RSTAT = WS_BAR + 16384;
constexpr size_t WS_XC = 3 * MiB;
constexpr size_t WS_W = 7 * MiB;
constexpr size_t WA_UZ = 0, WA_V = 8 * MiB, WA_OUT = 12 * MiB, WA_S = 16 * MiB, WA_SIZE = 16 * MiB + 262144;
constexpr size_t WB_QKZ = 0, WB_V = 4 * MiB + 524288, WB_OUT = 5 * MiB, WB_SIZE = 7 * MiB;
constexpr size_t WS_WA0 = WS_W, WS_WB0 = WS_W + 2 * WA_SIZE;
constexpr size_t WS_H = 54 * MiB;
constexpr size_t WS_ACT = 88 * MiB;
constexpr size_t ACT_UZ = 0, ACT_VTA = 68 * MiB;
constexpr size_t ACT_Q = 0, ACT_K = 34 * MiB, ACT_VTB = 34 * MiB + 8912896, ACT_Z = 52 * MiB, ACT_OZ = 86 * MiB;
constexpr size_t WS_END = 224 * MiB;
static_assert(WS_WB0 + 2 * WB_SIZE <= WS_H, "weights fit");
static_assert((size_t)T * 256 * 2 == 8912896, "kv size");
static_assert(ACT_VTB + 8912896 <= ACT_Z && ACT_OZ + 34 * MiB <= 136 * MiB, "act map");

DI unsigned cvtpk(float lo, float hi) { f32x2 v = {lo, hi}; bf16x2_t b = __builtin_convertvector(v, bf16x2_t); return __builtin_bit_cast(unsigned, b); }
DI float bflo(unsigned u) { return __uint_as_float(u << 16); }
DI float bfhi(unsigned u) { return __uint_as_float(u & 0xffff0000u); }
DI float fast_sigmoid(float t) { return __builtin_amdgcn_rcpf(1.0f + __builtin_amdgcn_exp2f(-LOG2E * t)); }
DI float gelu_t(float x) { const float t = x * (1.5957691216057308f + 0.07135481627183409f * x * x); return x * fast_sigmoid(t); }
DI float silu_f(float x) { return x * fast_sigmoid(x); }
typedef _Float16 h16x2 __attribute__((ext_vector_type(2)));
DI unsigned pkh(float lo, float hi) { const h16x2 v = {(_Float16)lo, (_Float16)hi}; return __builtin_bit_cast(unsigned, v); }
DI float hlo(unsigned u) { return (float)__builtin_bit_cast(h16x2, u).x; }
DI float hhi(unsigned u) { return (float)__builtin_bit_cast(h16x2, u).y; }
DI int opaque_tid() { int t = threadIdx.x; asm volatile("" : "+v"(t)); return t; }
template <int CTRL> DI float dpp_add(float v) { return v + __builtin_bit_cast(float, __builtin_amdgcn_update_dpp(0, __builtin_bit_cast(int, v), CTRL, 0xf, 0xf, false)); }
DI float max3f(float a, float b, float c) { float r; asm("v_max3_f32 %0, %1, %2, %3" : "=v"(r) : "v"(a), "v"(b), "v"(c)); return r; }
DI f32x2 exp2_2(f32x2 v) { return (f32x2){__builtin_amdgcn_exp2f(v.x), __builtin_amdgcn_exp2f(v.y)}; }
DI f32x2 rcp_2(f32x2 v) { return (f32x2){__builtin_amdgcn_rcpf(v.x), __builtin_amdgcn_rcpf(v.y)}; }
constexpr float GELU_A = -1.5957691216057308f * LOG2E, GELU_B = -0.07135481627183409f * LOG2E;
DI f32x2 gelu_silu_pk(f32x2 u, f32x2 z) { const f32x2 p = (u * u) * GELU_B + GELU_A; const f32x2 e1 = exp2_2(u * p), e2 = exp2_2(z * (-LOG2E)); return (u * z) * rcp_2((e1 + 1.0f) * (e2 + 1.0f)); }
DI f32x2 gelu_pk2(f32x2 u) { const f32x2 p = (u * u) * GELU_B + GELU_A; return u * rcp_2(exp2_2(u * p) + 1.0f); }
DI f32x2 silu_pk2(f32x2 z) { return z * rcp_2(exp2_2(z * (-LOG2E)) + 1.0f); }
DI float xhalf_f(float v) { const unsigned u = __builtin_bit_cast(unsigned, v);
#if __has_builtin(__builtin_amdgcn_permlane32_swap)
    const auto r = __builtin_amdgcn_permlane32_swap(u, u, false, false); const unsigned lo = r[0], hi = r[1];
    return __builtin_bit_cast(float, (threadIdx.x & 32) ? lo : hi);
#else
    return __shfl_xor(v, 32);
#endif
}
DI float wave_sum_dpp(float v) {
    v = dpp_add<0xB1>(v); v = dpp_add<0x4E>(v); v = dpp_add<0x141>(v); v = dpp_add<0x140>(v);
    v += __shfl_xor(v, 16); v += __shfl_xor(v, 32);
    return v;
}
DI float wave_sum(float v) {
#pragma unroll
    for (int o = 1; o < 64; o <<= 1) v += __shfl_xor(v, o);
    return v;
}

namespace pg8 {
#define PG8_LAS __attribute__((address_space(3)))
constexpr int BM = 256, BK = 64, HALF = 128, HTB = HALF * BK * 2, STAGE_BYTES = 8 * HTB, NXCD = 8, WGM = 8;
__host__ __device__ __forceinline__ int lds_byte(int r, int c) { const int st = (r >> 4) * 2 + (c >> 5), rr = r & 15, cc = c & 31, ob = rr * 64 + cc * 2; return st * 1024 + (ob ^ (((ob >> 9) & 1) << 5)); }
__host__ __device__ __forceinline__ void stage_rc(int b, int& R, int& C) { const int st = b / 1024, sb = b % 1024, swz = sb ^ (((sb >> 9) & 1) << 5); R = (st >> 1) * 16 + swz / 64; C = (st & 1) * 32 + (swz % 64) / 2; }
__host__ __device__ __forceinline__ int perm32(int rho) { const int n = rho >> 4, i = rho & 15; return 8 * (i >> 2) + 4 * n + (i & 3); }

struct Unit { int pm, pn; };

struct VSched {
    int nM, nN, nwg, G, c, nsplit; const char* A0; const char* B0; const char* A1; size_t tstep;
    DI void init(int nM_, int nN_, int nsplit_, int G_, int c_, const void* a0, const void* b0, const void* a1, int K) {
        nM = nM_; nN = nN_; nwg = nM * nN; G = G_; c = c_; nsplit = nsplit_; A0 = (const char*)a0; B0 = (const char*)b0; A1 = (const char*)a1; tstep = (size_t)BM * K * 2; }
    DI bool next(int i, Unit& u) const {
        const long L = (long)i * G + c; if (L >= nwg) return false;
        int wgid = (int)L; { const int q = nwg / NXCD, r = nwg % NXCD, xcd = wgid % NXCD, off = wgid / NXCD; wgid = (xcd < r ? xcd * (q + 1) : r * (q + 1) + (xcd - r) * q) + off; }
        const int nig = WGM * nN, gid = wgid / nig, fm = gid * WGM, gsz = (nM - fm) < WGM ? (nM - fm) : WGM;
        u.pm = fm + ((wgid % nig) % gsz); u.pn = (wgid % nig) / gsz; return true;
    }
    DI const char* pa(const Unit& u) const { return u.pn < nsplit ? A0 + (size_t)u.pm * tstep : A1 + (size_t)(u.pn - nsplit) * tstep; }
    DI const char* pb(const Unit& u) const { return u.pn < nsplit ? B0 + (size_t)u.pn * tstep : A0 + (size_t)u.pm * tstep; }
};

template <class Epi, bool ALIGN_EPI, bool SP2>
__device__ __forceinline__ void gemm_phase(PG8_LAS unsigned char* lds, const int K, const VSched& S, const Epi& E) {
    const int tid = opaque_tid(), wid = __builtin_amdgcn_readfirstlane(tid >> 6), lane = tid & 63, wr = wid >> 2, wc = wid & 3, fr = lane & 15, fq = lane >> 4;
    const int nt = K / BK;
    unsigned voffA[2], voffB[2];
#pragma unroll
    for (int i = 0; i < 2; ++i) { int R, C; stage_rc(tid * 16 + i * 8192, R, C); const int Rb = Epi::PERM ? ((R & ~31) + perm32(R & 31)) : R;
        voffA[i] = (unsigned)(R * K + C) * 2u; voffB[i] = (unsigned)(Rb * K + C) * 2u; }
    const size_t kstep = (size_t)(BK * 2);
    const size_t hstep = (size_t)HALF * K * 2;
    const unsigned ldsw = (unsigned)wid * 1024u;
    const int aoff = lds_byte(wr * 64 + fr, fq * 8), boff = lds_byte(wc * 32 + fr, fq * 8);
#define PG8_SA(b, h) (((b) * 2 + (h)) * HTB)
#define PG8_SB(b, h) ((4 + (b) * 2 + (h)) * HTB)
#define PG8_STAGE(bufoff, gbase, voff) do { _Pragma("unroll") for (int _i = 0; _i < 2; ++_i) \
        __builtin_amdgcn_global_load_lds((const unsigned*)((const char*)(gbase) + (voff)[_i]), (PG8_LAS unsigned*)(lds + (bufoff) + ldsw + _i * 8192), 16, 0, 0); } while (0)
#define PG8_LDA(dst, b, h) do { _Pragma("unroll") for (int m = 0; m < 4; ++m) _Pragma("unroll") for (int k = 0; k < 2; ++k) dst[m][k] = *(const PG8_LAS bf16x8*)(lds + PG8_SA(b, h) + aoff + m * 2048 + k * 1024); } while (0)
#define PG8_LDB(dst, b, h) do { _Pragma("unroll") for (int n = 0; n < 2; ++n) _Pragma("unroll") for (int k = 0; k < 2; ++k) dst[n][k] = *(const PG8_LAS bf16x8*)(lds + PG8_SB(b, h) + boff + n * 2048 + k * 1024); } while (0)
#define PG8_MMA(ai, bj, At, Bt) do { __builtin_amdgcn_s_setprio(1); _Pragma("unroll") for (int m = 0; m < 4; ++m) _Pragma("unroll") for (int n = 0; n < 2; ++n) _Pragma("unroll") for (int k = 0; k < 2; ++k) \
        acc[ai][bj][m][n] = __builtin_amdgcn_mfma_f32_16x16x32_bf16(Bt[n][k], At[m][k], acc[ai][bj][m][n], 0, 0, 0); __builtin_amdgcn_s_setprio(0); } while (0)
#define PG8_WAIT_V(n) asm volatile("s_waitcnt vmcnt(" #n ")" ::: "memory")
#define PG8_WAIT_L(n) asm volatile("s_waitcnt lgkmcnt(" #n ")" ::: "memory")
#define PG8_BAR __builtin_amdgcn_s_barrier()
#define PG8_SCHED __builtin_amdgcn_sched_barrier(0)
    Unit cur, nxt; int ui = 0;
    if (!S.next(0, cur)) return;
    f32x4 acc[2][2][4][2];
#pragma unroll
    for (int a = 0; a < 2; ++a)
#pragma unroll
        for (int b = 0; b < 2; ++b)
#pragma unroll
            for (int m = 0; m < 4; ++m)
#pragma unroll
                for (int n = 0; n < 2; ++n) acc[a][b][m][n] = (f32x4){0.f, 0.f, 0.f, 0.f};
    bf16x8 At[4][2], B0[2][2], B1[2][2];
    const char* cA = S.pa(cur); const char* cB = S.pb(cur);
    if constexpr (SP2) {
        PG8_STAGE(PG8_SB(0, 0), cB, voffB); PG8_STAGE(PG8_SB(0, 1), cB + hstep, voffB); PG8_STAGE(PG8_SA(0, 0), cA, voffA); PG8_STAGE(PG8_SA(0, 1), cA + hstep, voffA);
        if (wr == 1) PG8_BAR;
        PG8_WAIT_V(2); PG8_BAR;
        PG8_STAGE(PG8_SB(1, 0), cB + kstep, voffB); PG8_STAGE(PG8_SA(1, 0), cA + kstep, voffA); PG8_STAGE(PG8_SB(1, 1), cB + hstep + kstep, voffB);
        PG8_WAIT_V(6); PG8_BAR;
    } else {
        PG8_STAGE(PG8_SB(0, 0), cB, voffB); PG8_STAGE(PG8_SA(0, 0), cA, voffA); PG8_STAGE(PG8_SB(0, 1), cB + hstep, voffB); PG8_STAGE(PG8_SA(0, 1), cA + hstep, voffA);
        if (wr == 1) PG8_BAR;
        PG8_WAIT_V(4); PG8_BAR;
        PG8_STAGE(PG8_SB(1, 0), cB + kstep, voffB); PG8_STAGE(PG8_SA(1, 0), cA + kstep, voffA); PG8_STAGE(PG8_SB(1, 1), cB + hstep + kstep, voffB);
        PG8_WAIT_V(6); PG8_BAR;
    }
    for (;;) {
        const bool has_next = S.next(ui + 1, nxt);
        const char* nA = has_next ? S.pa(nxt) : cA; const char* nB = has_next ? S.pb(nxt) : cB;
        for (int t = 0; t < nt; t += 2) {
            const bool last = (t == nt - 2);
            const char* a1 = cA + (size_t)(t + 1) * kstep;
            const char* a2 = last ? nA : cA + (size_t)(t + 2) * kstep; const char* b2 = last ? nB : cB + (size_t)(t + 2) * kstep;
            const char* a3 = a2 + kstep; const char* b3 = b2 + kstep;
            if constexpr (SP2) {
            PG8_LDB(B0, 0, 0); PG8_LDB(B1, 0, 1); PG8_SCHED; PG8_LDA(At, 0, 0); PG8_STAGE(PG8_SA(1, 1), a1 + hstep, voffA);
            PG8_WAIT_V(8); PG8_WAIT_L(0); PG8_BAR; PG8_MMA(0, 0, At, B0); PG8_MMA(0, 1, At, B1); PG8_BAR; PG8_SCHED;
            PG8_LDA(At, 0, 1); PG8_STAGE(PG8_SB(0, 0), b2, voffB); PG8_STAGE(PG8_SB(0, 1), b2 + hstep, voffB); PG8_STAGE(PG8_SA(0, 0), a2, voffA);
            PG8_WAIT_V(8); PG8_WAIT_L(0); PG8_BAR; PG8_MMA(1, 0, At, B0); PG8_MMA(1, 1, At, B1); PG8_BAR; PG8_SCHED;
            PG8_LDB(B0, 1, 0); PG8_LDB(B1, 1, 1); PG8_SCHED; PG8_LDA(At, 1, 0); PG8_STAGE(PG8_SA(0, 1), a2 + hstep, voffA);
            PG8_WAIT_V(8); PG8_WAIT_L(0); PG8_BAR; PG8_MMA(0, 0, At, B0); PG8_MMA(0, 1, At, B1); PG8_BAR; PG8_SCHED;
            PG8_LDA(At, 1, 1); PG8_STAGE(PG8_SB(1, 0), b3, voffB); PG8_STAGE(PG8_SB(1, 1), b3 + hstep, voffB); PG8_STAGE(PG8_SA(1, 0), a3, voffA);
            PG8_WAIT_V(8); PG8_WAIT_L(0); PG8_BAR; PG8_MMA(1, 0, At, B0); PG8_MMA(1, 1, At, B1); PG8_BAR; PG8_SCHED;
            } else {
            PG8_LDB(B0, 0, 0); PG8_SCHED; PG8_LDA(At, 0, 0); PG8_STAGE(PG8_SA(1, 1), a1 + hstep, voffA);
            PG8_WAIT_L(8); PG8_BAR; PG8_WAIT_L(0); PG8_MMA(0, 0, At, B0); PG8_BAR; PG8_SCHED;
            PG8_LDB(B1, 0, 1); PG8_STAGE(PG8_SB(0, 0), b2, voffB);
            PG8_BAR; PG8_WAIT_L(0); PG8_MMA(0, 1, At, B1); PG8_BAR;
            PG8_LDA(At, 0, 1); PG8_STAGE(PG8_SA(0, 0), a2, voffA);
            PG8_BAR; PG8_WAIT_L(0); PG8_MMA(1, 0, At, B0); PG8_BAR; PG8_SCHED;
            PG8_STAGE(PG8_SB(0, 1), b2 + hstep, voffB);
            PG8_WAIT_V(6); PG8_BAR; PG8_MMA(1, 1, At, B1); PG8_BAR;
            PG8_LDB(B0, 1, 0); PG8_SCHED; PG8_LDA(At, 1, 0); PG8_STAGE(PG8_SA(0, 1), a2 + hstep, voffA);
            PG8_WAIT_L(8); PG8_BAR; PG8_WAIT_L(0); PG8_MMA(0, 0, At, B0); PG8_BAR; PG8_SCHED;
            PG8_LDB(B1, 1, 1); PG8_STAGE(PG8_SB(1, 0), b3, voffB);
            PG8_BAR; PG8_WAIT_L(0); PG8_MMA(0, 1, At, B1); PG8_BAR;
            PG8_LDA(At, 1, 1); PG8_STAGE(PG8_SA(1, 0), a3, voffA);
            PG8_BAR; PG8_WAIT_L(0); PG8_MMA(1, 0, At, B0); PG8_BAR; PG8_SCHED;
            PG8_STAGE(PG8_SB(1, 1), b3 + hstep, voffB);
            PG8_WAIT_V(6); PG8_BAR; PG8_MMA(1, 1, At, B1); PG8_BAR;
            }
        }
        if constexpr (ALIGN_EPI) { if (wr == 0) PG8_BAR; }
        { int fr2 = fr, fq2 = fq; asm volatile("" : "+v"(fr2), "+v"(fq2)); E(acc, cur, wr, wc, fr2, fq2); }
        if (!has_next) break;
#pragma unroll
        for (int a = 0; a < 2; ++a)
#pragma unroll
            for (int b = 0; b < 2; ++b)
#pragma unroll
                for (int m = 0; m < 4; ++m)
#pragma unroll
                    for (int n = 0; n < 2; ++n) acc[a][b][m][n] = (f32x4){0.f, 0.f, 0.f, 0.f};
        cur = nxt; cA = nA; cB = nB; ++ui;
        if constexpr (ALIGN_EPI) { if (wr == 1) PG8_BAR; }
    }
    PG8_WAIT_V(0);
    if constexpr (!ALIGN_EPI) { if (wr == 0) PG8_BAR; }
    PG8_BAR;
#undef PG8_SA
#undef PG8_SB
#undef PG8_STAGE
#undef PG8_LDA
#undef PG8_LDB
#undef PG8_MMA
#undef PG8_WAIT_V
#undef PG8_WAIT_L
#undef PG8_BAR
#undef PG8_SCHED
}
}
using pg8::Unit;

struct EpiG1A {
    static constexpr bool PERM = true;
    bf16_t* UZ; bf16_t* VT; float* stat;
    DI void operator()(const f32x4 (&acc)[2][2][4][2], const Unit& u, int wr, int wc, int fr, int fq) const {
        if (u.pn < 16) {
#ifndef NO_UZ
            const int row0 = u.pm * 256 + wr * 64 + fr, col0 = u.pn * 128 + wc * 32 + 8 * fq;
#pragma unroll
            for (int ai = 0; ai < 2; ++ai)
#pragma unroll
                for (int m = 0; m < 4; ++m) {
                    const f32x4 u0 = acc[ai][0][m][0], u1 = acc[ai][0][m][1], z0 = acc[ai][1][m][0], z1 = acc[ai][1][m][1];
                    const f32x2 oa = gelu_silu_pk((f32x2){u0[0], u0[1]}, (f32x2){z0[0], z0[1]}), ob = gelu_silu_pk((f32x2){u0[2], u0[3]}, (f32x2){z0[2], z0[3]});
                    const f32x2 oc = gelu_silu_pk((f32x2){u1[0], u1[1]}, (f32x2){z1[0], z1[1]}), od = gelu_silu_pk((f32x2){u1[2], u1[3]}, (f32x2){z1[2], z1[3]});
                    u32x4 w; w.x = cvtpk(oa.x, oa.y); w.y = cvtpk(ob.x, ob.y); w.z = cvtpk(oc.x, oc.y); w.w = cvtpk(od.x, od.y);
                    *(u32x4*)(UZ + (size_t)(row0 + ai * 128 + m * 16) * AW + col0) = w;
                }
#endif
        } else {
#ifndef NO_VT
            const int ct = u.pn - 16;
            const int ch0 = ct * 256 + wr * 64 + fr, tok0 = u.pm * 256 + wc * 32 + 8 * fq;
            float one = 1.0f; asm volatile("" : "+v"(one));
#pragma unroll
            for (int bj = 0; bj < 2; ++bj) {
                float s1[8], s2[8];
#pragma unroll
                for (int t = 0; t < 8; ++t) { s1[t] = 0.f; s2[t] = 0.f; }
#pragma unroll
                for (int ai = 0; ai < 2; ++ai)
#pragma unroll
                    for (int m = 0; m < 4; ++m) {
                        float g[8];
#pragma unroll
                        for (int j = 0; j < 4; ++j) { g[j] = gelu_t(acc[ai][bj][m][0][j] * one); g[4 + j] = gelu_t(acc[ai][bj][m][1][j] * one); }
#pragma unroll
                        for (int j = 0; j < 8; ++j) { s1[j] += g[j]; s2[j] += g[j] * g[j]; }
                        u32x4 w; w.x = cvtpk(g[0], g[1]); w.y = cvtpk(g[2], g[3]); w.z = cvtpk(g[4], g[5]); w.w = cvtpk(g[6], g[7]);
                        *(u32x4*)(VT + (size_t)(ch0 + ai * 128 + m * 16) * T + tok0 + bj * 128) = w;
                    }
#pragma unroll
                for (int k = 0; k < 8; ++k) {
                    s1[k] = dpp_add<0xB1>(s1[k]); s2[k] = dpp_add<0xB1>(s2[k]);
                    s1[k] = dpp_add<0x4E>(s1[k]); s2[k] = dpp_add<0x4E>(s2[k]);
                    s1[k] = dpp_add<0x141>(s1[k]); s2[k] = dpp_add<0x141>(s2[k]);
                    s1[k] = dpp_add<0x140>(s1[k]); s2[k] = dpp_add<0x140>(s2[k]); }
#pragma unroll
                for (int k = 1; k < 8; ++k) { s1[0] = (fr == k) ? s1[k] : s1[0]; s2[0] = (fr == k) ? s2[k] : s2[0]; }
                if (fr < 8) { const int tok = tok0 + bj * 128 + fr;
                    *(f32x2*)(stat + ((size_t)tok * 16 + ct * 2 + wr) * 2) = (f32x2){s1[0], s2[0]}; }
            }
#endif
        }
    }
};

struct EpiG1B {
    static constexpr bool PERM = true;
    bf16_t* Q; bf16_t* Kb; bf16_t* Z; bf16_t* VT; const LAS float* rope;
    DI void operator()(const f32x4 (&acc)[2][2][4][2], const Unit& u, int wr, int wc, int fr, int fq) const {
        if (u.pn <= 4) {
            const bool isq = u.pn < 4, latent = u.pm < 64;
            const float sc = isq ? 0.125f * LOG2E : 1.0f;
            const int axis = wc & 1, f0 = 8 * (fq & 1);
            const float sgn = (fq < 2) ? -1.f : 1.f;
            bf16_t* base = isq ? Q + u.pn * 256 : Kb; const int ld = isq ? 1024 : 256;
#pragma unroll
            for (int ai = 0; ai < 2; ++ai)
#pragma unroll
                for (int m = 0; m < 4; ++m) {
                    const int row = u.pm * 256 + ai * 128 + wr * 64 + m * 16 + fr;
                    const int t = row & 4095, pos = axis ? (t & 63) : (t >> 6);
                    f32x4 c0 = {1.f, 1.f, 1.f, 1.f}, c1 = c0, s0 = {0.f, 0.f, 0.f, 0.f}, s1 = s0;
                    if (latent) { const LAS float* cp = rope + pos * 16 + f0; c0 = *(const LAS f32x4*)cp; c1 = *(const LAS f32x4*)(cp + 4); s0 = *(const LAS f32x4*)(cp + 1024); s1 = *(const LAS f32x4*)(cp + 1028); }
#pragma unroll
                    for (int bj = 0; bj < 2; ++bj) {
                        const f32x4 v0 = acc[ai][bj][m][0], v1 = acc[ai][bj][m][1];
                        float o[8];
#pragma unroll
                        for (int j = 0; j < 4; ++j) {
                            const float p0 = __shfl_xor(v0[j], 32), p1 = __shfl_xor(v1[j], 32);
                            o[j] = (v0[j] * c0[j] + sgn * p0 * s0[j]) * sc; o[4 + j] = (v1[j] * c1[j] + sgn * p1 * s1[j]) * sc; }
                        u32x4 w; w.x = cvtpk(o[0], o[1]); w.y = cvtpk(o[2], o[3]); w.z = cvtpk(o[4], o[5]); w.w = cvtpk(o[6], o[7]);
                        *(u32x4*)(base + (size_t)row * ld + bj * 128 + wc * 32 + 8 * fq) = w;
                    }
                }
        } else if (u.pn < 9) {
            bf16_t* base = Z + (u.pn - 5) * 256 + wc * 32 + 8 * fq;
#pragma unroll
            for (int ai = 0; ai < 2; ++ai)
#pragma unroll
                for (int m = 0; m < 4; ++m) {
                    const int row = u.pm * 256 + ai * 128 + wr * 64 + m * 16 + fr;
#pragma unroll
                    for (int bj = 0; bj < 2; ++bj) {
                        const f32x4 v0 = acc[ai][bj][m][0], v1 = acc[ai][bj][m][1];
                        const f32x2 sa = silu_pk2((f32x2){v0[0], v0[1]}), sb = silu_pk2((f32x2){v0[2], v0[3]}), sc2 = silu_pk2((f32x2){v1[0], v1[1]}), sd = silu_pk2((f32x2){v1[2], v1[3]});
                        u32x4 w; w.x = cvtpk(sa.x, sa.y); w.y = cvtpk(sb.x, sb.y); w.z = cvtpk(sc2.x, sc2.y); w.w = cvtpk(sd.x, sd.y);
                        *(u32x4*)(base + (size_t)row * 1024 + bj * 128) = w;
                    }
                }
        } else {
            const int tok0 = u.pm * 256 + wc * 32 + 8 * fq;
#pragma unroll
            for (int ai = 0; ai < 2; ++ai)
#pragma unroll
                for (int m = 0; m < 4; ++m) {
                    const int ch = ai * 128 + wr * 64 + m * 16 + fr;
#pragma unroll
                    for (int bj = 0; bj < 2; ++bj) {
                        const f32x4 v0 = acc[ai][bj][m][0], v1 = acc[ai][bj][m][1];
                        u32x4 w; w.x = cvtpk(v0[0], v0[1]); w.y = cvtpk(v0[2], v0[3]); w.z = cvtpk(v1[0], v1[1]); w.w = cvtpk(v1[2], v1[3]);
                        *(u32x4*)(VT + (size_t)ch * T + tok0 + bj * 128) = w;
                    }
                }
        }
    }
};

struct EpiG2 {
    static constexpr bool PERM = true;
    const float* x0; const unsigned short* rsrc; unsigned short* rdst;
    const float* xc0; unsigned short* rc;
    const float* gate; const float* rstat; const float* png; const float* pnb;
    DI void operator()(const f32x4 (&acc)[2][2][4][2], const Unit& u, int wr, int wc, int fr, int fq) const {
        const bool norm = x0 == nullptr;
        const int cb = u.pn * 256 + wc * 32 + 8 * fq;
        const float* gp = gate + (u.pm >> 4) * 3072 + cb;
        const int rbase = u.pm * 256 + wr * 64 + fr;
        const float* sp = rstat + (size_t)rbase * 2;
#pragma unroll
        for (int bj = 0; bj < 2; ++bj) {
            const int co = bj * 128;
            const f32x4 g0 = *(const f32x4*)(gp + co), g1 = *(const f32x4*)(gp + co + 4);
            f32x4 ng0 = {1.f, 1.f, 1.f, 1.f}, ng1 = ng0, nb0 = {0.f, 0.f, 0.f, 0.f}, nb1 = nb0;
            if (norm) { ng0 = *(const f32x4*)(png + cb + co); ng1 = *(const f32x4*)(png + cb + co + 4); nb0 = *(const f32x4*)(pnb + cb + co); nb1 = *(const f32x4*)(pnb + cb + co + 4); }
#pragma unroll
            for (int ai = 0; ai < 2; ++ai) {
                f32x4 xa[4], xb[4];
                if (norm) { u32x4 rv[4]; f32x2 st[4];
#pragma unroll
                    for (int m = 0; m < 4; ++m) { const int ro = ai * 128 + m * 16; rv[m] = *(const u32x4*)(rsrc + (size_t)(rbase + ro) * DM + cb + co); st[m] = *(const f32x2*)(sp + ro * 2); }
#pragma unroll
                    for (int m = 0; m < 4; ++m) { xa[m] = (f32x4){hlo(rv[m].x), hhi(rv[m].x), hlo(rv[m].y), hhi(rv[m].y)}; xb[m] = (f32x4){hlo(rv[m].z), hhi(rv[m].z), hlo(rv[m].w), hhi(rv[m].w)};
                        xa[m] = (xa[m] - st[m].x) * st[m].y * ng0 + nb0; xb[m] = (xb[m] - st[m].x) * st[m].y * ng1 + nb1; } }
                else {
#pragma unroll
                    for (int m = 0; m < 4; ++m) { const size_t off = (size_t)(rbase + ai * 128 + m * 16) * DM + cb + co;
                        xa[m] = __builtin_nontemporal_load((const f32x4*)(x0 + off)); xb[m] = __builtin_nontemporal_load((const f32x4*)(x0 + off + 4)); } }
#pragma unroll
                for (int m = 0; m < 4; ++m) { const size_t off = (size_t)(rbase + ai * 128 + m * 16) * DM + cb + co;
                    const f32x4 ra = xa[m] * ALPHA + g0 * acc[ai][bj][m][0], rb = xb[m] * ALPHA + g1 * acc[ai][bj][m][1];
                    u32x4 w; w.x = pkh(ra[0], ra[1]); w.y = pkh(ra[2], ra[3]); w.z = pkh(rb[0], rb[1]); w.w = pkh(rb[2], rb[3]);
                    *(u32x4*)(rdst + off) = w; }
            }
        }
    }
};

struct Params {
    const float* x; const float* c; const float* ctx; const float* c_ctx; const float* ada_w; const float* ada_b; const float* ln_g; const float* ln_b;
    const float* a_w_in; const float* a_ln_g; const float* a_ln_b; const float* a_w_s; const float* a_b_s; const float* a_w_out;
    const float* b_w_in; const float* b_sink; const float* b_w_out;
    float* out; unsigned char* ws;
};


DI void g2_ctx_small(const Params& P, LAS unsigned char* lds, const bf16_t* A  , const bf16_t* Bt, const int K, const EpiG2& E) {
    const int tid = opaque_tid(), lane = tid & 63, wave = __builtin_amdgcn_readfirstlane(tid >> 6);
    const int r16 = lane & 15, kq = lane >> 4;
    const int kw = K >> 3;
    LAS float* part = (LAS float*)lds;
    for (int tile = blockIdx.x; tile < 256; tile += gridDim.x) {
        const int tm = tile >> 4, tn = tile & 15;
        const bf16_t* ap = A + (size_t)(64 * tm + r16) * K + wave * kw + 8 * kq;
        const bf16_t* bp = Bt + (size_t)(64 * tn + r16) * K + wave * kw + 8 * kq;
        f32x4 acc[4][4];
#pragma unroll
        for (int i = 0; i < 4; ++i)
#pragma unroll
            for (int jj = 0; jj < 4; ++jj) acc[i][jj] = (f32x4){0.f, 0.f, 0.f, 0.f};
        bf16x8 a[2][4], b[2][4];
#pragma unroll
        for (int i = 0; i < 4; ++i) { a[0][i] = *(const bf16x8*)(ap + (size_t)(16 * i) * K); b[0][i] = *(const bf16x8*)(bp + (size_t)(16 * i) * K); }
#pragma unroll 1
        for (int k0 = 0; k0 < kw; k0 += 64) {
#pragma unroll
            for (int i = 0; i < 4; ++i) { a[1][i] = *(const bf16x8*)(ap + (size_t)(16 * i) * K + k0 + 32); b[1][i] = *(const bf16x8*)(bp + (size_t)(16 * i) * K + k0 + 32); }
#pragma unroll
            for (int i = 0; i < 4; ++i)
#pragma unroll
                for (int jj = 0; jj < 4; ++jj) acc[i][jj] = __builtin_amdgcn_mfma_f32_16x16x32_bf16(a[0][i], b[0][jj], acc[i][jj], 0, 0, 0);
            const int kn = (k0 + 64 < kw) ? (k0 + 64) : (kw - 32);
#pragma unroll
            for (int i = 0; i < 4; ++i) { a[0][i] = *(const bf16x8*)(ap + (size_t)(16 * i) * K + kn); b[0][i] = *(const bf16x8*)(bp + (size_t)(16 * i) * K + kn); }
#pragma unroll
            for (int i = 0; i < 4; ++i)
#pragma unroll
                for (int jj = 0; jj < 4; ++jj) acc[i][jj] = __builtin_amdgcn_mfma_f32_16x16x32_bf16(a[1][i], b[1][jj], acc[i][jj], 0, 0, 0);
        }
        __syncthreads();
#pragma unroll
        for (int i = 0; i < 4; ++i)
#pragma unroll
            for (int jj = 0; jj < 4; ++jj)
#pragma unroll
                for (int q = 0; q < 4; ++q) part[wave * 4096 + (16 * i + 4 * kq + q) * 64 + 16 * jj + r16] = acc[i][jj][q];
        __syncthreads();
        { const int row = tid >> 3, c0 = (tid & 7) * 8;
          f32x4 s0 = {0.f, 0.f, 0.f, 0.f}, s1 = s0;
#pragma unroll
          for (int w = 0; w < 8; ++w) { s0 += *(const LAS f32x4*)(part + w * 4096 + row * 64 + c0); s1 += *(const LAS f32x4*)(part + w * 4096 + row * 64 + c0 + 4); }
          const int crow = 64 * tm + row, col = 64 * tn + c0;
          const float* gp = E.gate + 4 * 3072 + col;
          const size_t off = (size_t)crow * DM + col;
          f32x4 x0, x1;
          if (E.xc0 != nullptr) { x0 = *(const f32x4*)(E.xc0 + off); x1 = *(const f32x4*)(E.xc0 + off + 4); }
          else { const u32x4 rv = *(const u32x4*)(E.rc + off); const f32x2 st = *(const f32x2*)(E.rstat + (size_t)(TL + crow) * 2);
              x0 = (f32x4){hlo(rv.x), hhi(rv.x), hlo(rv.y), hhi(rv.y)}; x1 = (f32x4){hlo(rv.z), hhi(rv.z), hlo(rv.w), hhi(rv.w)};
              x0 = (x0 - st.x) * st.y * *(const f32x4*)(E.png + col) + *(const f32x4*)(E.pnb + col);
              x1 = (x1 - st.x) * st.y * *(const f32x4*)(E.png + col + 4) + *(const f32x4*)(E.pnb + col + 4); }
          const f32x4 ra = x0 * ALPHA + *(const f32x4*)gp * s0, rb = x1 * ALPHA + *(const f32x4*)(gp + 4) * s1;
          u32x4 w; w.x = pkh(ra[0], ra[1]); w.y = pkh(ra[2], ra[3]); w.z = pkh(rb[0], rb[1]); w.w = pkh(rb[2], rb[3]);
          *(u32x4*)(E.rc + off) = w; }
    }
    __syncthreads();
}

DI void transpose_item(const float* W, int N, int K, bf16_t* WTrow  , int k0, int n0, LAS float* scr, int lane) {
    f32x4 tv[8];
#pragma unroll
    for (int i = 0; i < 8; ++i) tv[i] = __builtin_nontemporal_load((const f32x4*)(W + (size_t)(k0 + 8 * i + (lane >> 3)) * N + n0 + 4 * (lane & 7)));
#pragma unroll
    for (int i = 0; i < 8; ++i) { LAS float* d = scr + (8 * i + (lane >> 3)) * 33 + 4 * (lane & 7); d[0] = tv[i][0]; d[1] = tv[i][1]; d[2] = tv[i][2]; d[3] = tv[i][3]; }
    asm volatile("s_waitcnt lgkmcnt(0)" ::: "memory");
    const int c = lane & 7;
#pragma unroll
    for (int j = 0; j < 4; ++j) { const int n = (lane >> 3) + 8 * j; const LAS float* s = scr + (8 * c) * 33 + n;
        u32x4 o; o.x = cvtpk(s[0 * 33], s[1 * 33]); o.y = cvtpk(s[2 * 33], s[3 * 33]); o.z = cvtpk(s[4 * 33], s[5 * 33]); o.w = cvtpk(s[6 * 33], s[7 * 33]);
        *(u32x4*)(WTrow + (size_t)n * K + k0 + 8 * c) = o; }
    asm volatile("s_waitcnt lgkmcnt(0)" ::: "memory");
}

DI void p0_prologue(const Params& P, LAS unsigned char* lds) {
    const int tid = opaque_tid(), lane = tid & 63, wave = __builtin_amdgcn_readfirstlane(tid >> 6);
    unsigned char* ws = P.ws;
    {
        LAS float* scond = (LAS float*)lds;
        LAS float* red = (LAS float*)(lds + 32768);
        for (int idx = tid; idx < 5 * 1024; idx += NTHREADS) { const int r = idx >> 10, k = idx & 1023; const float v = r < 4 ? P.c[r * 1024 + k] : P.c_ctx[k]; scond[idx] = silu_f(v); }
        __syncthreads();
        for (int item = blockIdx.x; item < 192; item += gridDim.x) {
            const int li = item / 48, cc = item % 48, n = cc * 64 + lane;
            const float* wp = P.ada_w + (size_t)li * 1024 * 3072 + (size_t)(wave * 128) * 3072 + n;
            float a0 = 0.f, a1 = 0.f, a2 = 0.f, a3 = 0.f, a4 = 0.f;
#pragma unroll 1
            for (int kb = 0; kb < 128; kb += 32) {
                float wv[32];
#pragma unroll
                for (int k = 0; k < 32; ++k) wv[k] = __builtin_nontemporal_load(wp + (size_t)(kb + k) * 3072);
#pragma unroll
                for (int k = 0; k < 32; ++k) { const float w = wv[k]; const int kk = wave * 128 + kb + k;
                    a0 += scond[kk] * w; a1 += scond[1024 + kk] * w; a2 += scond[2048 + kk] * w; a3 += scond[3072 + kk] * w; a4 += scond[4096 + kk] * w; } }
            red[(wave * 5 + 0) * 64 + lane] = a0; red[(wave * 5 + 1) * 64 + lane] = a1; red[(wave * 5 + 2) * 64 + lane] = a2; red[(wave * 5 + 3) * 64 + lane] = a3; red[(wave * 5 + 4) * 64 + lane] = a4;
            __syncthreads();
            if (tid < 320) { const int r = tid >> 6, l = tid & 63; float s = P.ada_b[li * 3072 + cc * 64 + l];
#pragma unroll
                for (int w = 0; w < 8; ++w) s += red[(w * 5 + r) * 64 + l];
                ((float*)(ws + WS_MOD))[(li * 5 + r) * 3072 + cc * 64 + l] = s; }
            __syncthreads();
        }
    }
    if (blockIdx.x == gridDim.x - 1) {
        float* rope = (float*)(ws + WS_ROPE);
        for (int idx = tid; idx < 1024; idx += NTHREADS) { const int pos = idx >> 4, f = idx & 15;
            const float inv = exp2f(-(float)f * (13.287712379549449f / 16.0f)); const float ang = (float)pos * inv;
            rope[idx] = __cosf(ang); rope[1024 + idx] = __sinf(ang); }
    }
    __syncthreads();
    {
        LAS float* scr = (LAS float*)(lds + wave * 16384);
        const int gw = blockIdx.x * NWAVES + wave, NGW = gridDim.x * NWAVES;
        constexpr int I_AIN = 16 * 192, I_AOUT = 32 * 32, I_BIN = 16 * 80, I_BOUT = 16 * 32, I_PER = I_AIN + I_AOUT + I_BIN + I_BOUT;
        for (int it = gw; it < 2 * I_PER; it += NGW) {
            const int j = it / I_PER; int r = it % I_PER;
            unsigned char* wa = ws + WS_WA0 + (size_t)j * WA_SIZE; unsigned char* wb = ws + WS_WB0 + (size_t)j * WB_SIZE;
            if (r < I_AIN) { const int kb = r / 192, nb = r % 192, n0 = nb * 32; bf16_t* dst;
                if (n0 < 2048) dst = (bf16_t*)(wa + WA_UZ) + (size_t)(256 * (n0 >> 7) + (n0 & 127)) * 1024;
                else if (n0 < 4096) dst = (bf16_t*)(wa + WA_V) + (size_t)(n0 - 2048) * 1024;
                else { const int n1 = n0 - 4096; dst = (bf16_t*)(wa + WA_UZ) + (size_t)(256 * (n1 >> 7) + 128 + (n1 & 127)) * 1024; }
                transpose_item(P.a_w_in + (size_t)j * 1024 * 6144, 6144, 1024, dst, kb * 64, n0, scr, lane); continue; }
            r -= I_AIN;
            if (r < I_AOUT) { const int kb = r / 32, nb = r % 32, n0 = nb * 32;
                transpose_item(P.a_w_out + (size_t)j * 2048 * 1024, 1024, 2048, (bf16_t*)(wa + WA_OUT) + (size_t)n0 * 2048, kb * 64, n0, scr, lane); continue; }
            r -= I_AOUT;
            if (r < I_BIN) { const int kb = r / 80, nb = r % 80, n0 = nb * 32; bf16_t* dst;
                if (n0 < 1280) dst = (bf16_t*)(wb + WB_QKZ) + (size_t)n0 * 1024;
                else if (n0 < 1536) dst = (bf16_t*)(wb + WB_V) + (size_t)(n0 - 1280) * 1024;
                else dst = (bf16_t*)(wb + WB_QKZ) + (size_t)(n0 - 256) * 1024;
                transpose_item(P.b_w_in + (size_t)j * 1024 * 2560, 2560, 1024, dst, kb * 64, n0, scr, lane); continue; }
            r -= I_BIN;
            { const int kb = r / 32, nb = r % 32, n0 = nb * 32;
                transpose_item(P.b_w_out + (size_t)j * 1024 * 1024, 1024, 1024, (bf16_t*)(wb + WB_OUT) + (size_t)n0 * 1024, kb * 64, n0, scr, lane); }
        }
        const int gt = blockIdx.x * NTHREADS + tid, NGT = gridDim.x * NTHREADS;
        for (int i = gt; i < 2 * 8 * 128 * 128 / 8; i += NGT) { const int j = i >> 14, e = (i & 16383) * 8;
            const f32x4 v0 = *(const f32x4*)(P.a_w_s + (size_t)j * 131072 + e), v1 = *(const f32x4*)(P.a_w_s + (size_t)j * 131072 + e + 4);
            u32x4 w; w.x = cvtpk(v0[0], v0[1]); w.y = cvtpk(v0[2], v0[3]); w.z = cvtpk(v1[0], v1[1]); w.w = cvtpk(v1[2], v1[3]);
            *(u32x4*)((bf16_t*)(ws + WS_WA0 + (size_t)j * WA_SIZE + WA_S) + e) = w; }
    }
}

DI void p0b_h0(const Params& P) {
    const int tid = opaque_tid(), lane = tid & 63, wave = __builtin_amdgcn_readfirstlane(tid >> 6);
    const int gw = blockIdx.x * NWAVES + wave, NGW = gridDim.x * NWAVES;
    const float* mod = (const float*)(P.ws + WS_MOD);
    bf16_t* H = (bf16_t*)(P.ws + WS_H);
    for (int row = 2 * gw; row < T; row += 2 * NGW) {
        const float* xr = row < TL ? P.x + (size_t)row * DM : P.ctx + (size_t)(row - TL) * DM;
        const float* mr = mod + (row < TL ? (row >> 12) : 4) * 3072;
        f32x4 v[2][4], sh[4], sc[4];
#pragma unroll
        for (int q = 0; q < 2; ++q)
#pragma unroll
            for (int j = 0; j < 4; ++j) v[q][j] = __builtin_nontemporal_load((const f32x4*)(xr + q * DM + 4 * lane + 256 * j));
#pragma unroll
        for (int j = 0; j < 4; ++j) { const int c = 4 * lane + 256 * j; sh[j] = *(const f32x4*)(mr + c); sc[j] = *(const f32x4*)(mr + 1024 + c) + 1.0f; }
#pragma unroll
        for (int q = 0; q < 2; ++q)
#pragma unroll
            for (int j = 0; j < 4; ++j) { const int c = 4 * lane + 256 * j;
                const f32x4 h = v[q][j] * sc[j] + sh[j];
                u32x2 w; w.x = cvtpk(h[0], h[1]); w.y = cvtpk(h[2], h[3]);
                *(u32x2*)(H + (size_t)(row + q) * DM + c) = w; }
    }
}

DI void ln_phase(const Params& P, int layer) {
    const int tid = opaque_tid(), lane = tid & 63, wave = __builtin_amdgcn_readfirstlane(tid >> 6);
    const int gw = blockIdx.x * NWAVES + wave, NGW = gridDim.x * NWAVES;
    const bool last = layer == 3;
    const float* modn = (const float*)(P.ws + WS_MOD) + (layer + 1) * 15360;
    const float* lg = P.ln_g + layer * DM; const float* lb = P.ln_b + layer * DM;
    bf16_t* H = (bf16_t*)(P.ws + WS_H);
    const unsigned short* rl = last ? (const unsigned short*)(P.ws + WS_H) : (const unsigned short*)P.out;
    const unsigned short* rc = (const unsigned short*)(P.ws + WS_XC);
    float* rstat = (float*)(P.ws + WS_RSTAT);
    const int nrows = last ? TL : T;
    f32x4 g_[4], b_[4];
#pragma unroll
    for (int j = 0; j < 2; ++j) { const int c = 8 * lane + 512 * j; g_[2 * j] = *(const f32x4*)(lg + c); g_[2 * j + 1] = *(const f32x4*)(lg + c + 4); b_[2 * j] = *(const f32x4*)(lb + c); b_[2 * j + 1] = *(const f32x4*)(lb + c + 4); }
    for (int row = 2 * gw; row < nrows; row += 2 * NGW) {
        const unsigned short* xr = row < TL ? rl + (size_t)row * DM : rc + (size_t)(row - TL) * DM;
        const float* mr = modn + (row < TL ? (row >> 12) : 4) * 3072;
        u32x4 rv[2][2];
#pragma unroll
        for (int q = 0; q < 2; ++q)
#pragma unroll
            for (int j = 0; j < 2; ++j) rv[q][j] = *(const u32x4*)(xr + q * DM + 8 * lane + 512 * j);
        f32x4 G2_[4], B2_[4];
        if (!last) {
#pragma unroll
            for (int j = 0; j < 2; ++j) { const int c = 8 * lane + 512 * j;
                const f32x4 sca = *(const f32x4*)(mr + 1024 + c) + 1.0f, scb = *(const f32x4*)(mr + 1024 + c + 4) + 1.0f, sha = *(const f32x4*)(mr + c), shb = *(const f32x4*)(mr + c + 4);
                G2_[2 * j] = g_[2 * j] * sca; G2_[2 * j + 1] = g_[2 * j + 1] * scb; B2_[2 * j] = b_[2 * j] * sca + sha; B2_[2 * j + 1] = b_[2 * j + 1] * scb + shb; }
        } else {
#pragma unroll
            for (int i = 0; i < 4; ++i) { G2_[i] = g_[i]; B2_[i] = b_[i]; }
        }
        f32x4 v[2][4]; float s[2] = {0.f, 0.f};
#pragma unroll
        for (int q = 0; q < 2; ++q)
#pragma unroll
            for (int j = 0; j < 2; ++j) { const u32x4 t = rv[q][j];
                v[q][2 * j] = (f32x4){hlo(t.x), hhi(t.x), hlo(t.y), hhi(t.y)}; v[q][2 * j + 1] = (f32x4){hlo(t.z), hhi(t.z), hlo(t.w), hhi(t.w)}; }
#pragma unroll
        for (int q = 0; q < 2; ++q)
#pragma unroll
            for (int j = 0; j < 4; ++j) s[q] += (v[q][j][0] + v[q][j][1]) + (v[q][j][2] + v[q][j][3]);
#pragma unroll
        for (int q = 0; q < 2; ++q) s[q] = wave_sum_dpp(s[q]);
        float mean[2], s2[2] = {0.f, 0.f};
#pragma unroll
        for (int q = 0; q < 2; ++q) { mean[q] = s[q] * (1.f / DM);
#pragma unroll
            for (int j = 0; j < 4; ++j) { v[q][j] = v[q][j] - mean[q]; s2[q] += (v[q][j][0] * v[q][j][0] + v[q][j][1] * v[q][j][1]) + (v[q][j][2] * v[q][j][2] + v[q][j][3] * v[q][j][3]); } }
#pragma unroll
        for (int q = 0; q < 2; ++q) s2[q] = wave_sum_dpp(s2[q]);
#pragma unroll
        for (int q = 0; q < 2; ++q) {
            const float rstd = 1.0f / sqrtf(s2[q] * (1.f / DM) + LN_EPS);
#pragma unroll
            for (int j = 0; j < 2; ++j) { const int c = 8 * lane + 512 * j;
                const f32x4 ya = v[q][2 * j] * rstd * G2_[2 * j] + B2_[2 * j], yb = v[q][2 * j + 1] * rstd * G2_[2 * j + 1] + B2_[2 * j + 1];
                if (last) { float* op = P.out + (size_t)(row + q) * DM + c; __builtin_nontemporal_store(ya, (f32x4*)op); __builtin_nontemporal_store(yb, (f32x4*)(op + 4)); }
                else { u32x4 w; w.x = cvtpk(ya[0], ya[1]); w.y = cvtpk(ya[2], ya[3]); w.z = cvtpk(yb[0], yb[1]); w.w = cvtpk(yb[2], yb[3]);
                    *(u32x4*)(H + (size_t)(row + q) * DM + c) = w; }
            }
            if (!last && lane == 0) *(f32x2*)(rstat + (size_t)(row + q) * 2) = (f32x2){mean[q], rstd};
        }
    }
}

DI void spatial_mix(const Params& P, int j, LAS unsigned char* lds) {
    const int tid = opaque_tid(), lane = tid & 63, wave = __builtin_amdgcn_readfirstlane(tid >> 6);
    const bf16_t* Wsb = (const bf16_t*)(P.ws + WS_WA0 + (size_t)j * WA_SIZE + WA_S);
    const float* bs = P.a_b_s + j * 1024; const float* lng = P.a_ln_g + j * AW; const float* lnb = P.a_ln_b + j * AW;
    const bf16_t* VT = (const bf16_t*)(P.ws + WS_ACT + ACT_VTA); bf16_t* UZ = (bf16_t*)(P.ws + WS_ACT + ACT_UZ);
    const float* stat = (const float*)(P.ws + WS_STAT);
    LAS unsigned char* Wl = lds;
    LAS float* smu = (LAS float*)(lds + 36864);
    const int r16 = lane & 15, kq = lane >> 4;
    const bool hoist = (gridDim.x & 7) == 0 && gridDim.x * 8 >= 136 * 8;
    if (hoist) {
        const int g = blockIdx.x & 7;
#pragma unroll
        for (int i = 0; i < 4; ++i) { const int piece = tid + NTHREADS * i, row = piece >> 4, cp = piece & 15;
            *(LAS u32x4*)(Wl + row * 272 + cp * 16) = *(const u32x4*)(Wsb + (size_t)g * 16384 + row * 128 + cp * 8); }
        for (int t = tid; t < 8 * 128; t += NTHREADS) { const int it = t >> 7, item = blockIdx.x + it * gridDim.x;
            if (item < 136 * 8) { const float* sp = stat + (size_t)((item >> 3) * 128 + (t & 127)) * 32; float a = 0.f, b = 0.f;
#pragma unroll
                for (int q8 = 0; q8 < 8; ++q8) { const f32x4 q = *(const f32x4*)(sp + 4 * q8); a += q[0] + q[2]; b += q[1] + q[3]; }
                const float mu = a * (1.f / AW); const float var = fmaxf(b * (1.f / AW) - mu * mu, 0.f);
                smu[it * 256 + (t & 127)] = mu; smu[it * 256 + 128 + (t & 127)] = 1.0f / sqrtf(var + LN_EPS); } }
        __syncthreads();
    }
    int itn = 0;
    for (int item = blockIdx.x; item < 136 * 8; item += gridDim.x, ++itn) {
        const int chunk = item >> 3, g = item & 7;
        if (!hoist) {
        __syncthreads();
        if (tid < 128) { const float* sp = stat + (size_t)(chunk * 128 + tid) * 32; float a = 0.f, b = 0.f;
#pragma unroll
            for (int s = 0; s < 8; ++s) { const f32x4 q = *(const f32x4*)(sp + 4 * s); a += q[0] + q[2]; b += q[1] + q[3]; }
            const float mu = a * (1.f / AW); const float var = fmaxf(b * (1.f / AW) - mu * mu, 0.f);
            smu[tid] = mu; smu[128 + tid] = 1.0f / sqrtf(var + LN_EPS); }
#pragma unroll
        for (int i = 0; i < 4; ++i) { const int piece = tid + NTHREADS * i, row = piece >> 4, cp = piece & 15;
            *(LAS u32x4*)(Wl + row * 272 + cp * 16) = *(const u32x4*)(Wsb + (size_t)g * 16384 + row * 128 + cp * 8); }
        __syncthreads();
        }
        const LAS float* smu_i = smu + (hoist ? itn * 256 : 0); const LAS float* srs_i = smu_i + 128;
        const int cw = g * 256 + 32 * wave;
        u32x4 gvr[2][4]; float ga[2], be[2];
#pragma unroll
        for (int ct = 0; ct < 2; ++ct) { const int ch = cw + 8 * (r16 >> 2) + 4 * ct + (r16 & 3);
            ga[ct] = lng[ch]; be[ct] = lnb[ch];
#pragma unroll
            for (int ks = 0; ks < 4; ++ks) gvr[ct][ks] = *(const u32x4*)(VT + (size_t)ch * T + chunk * 128 + 32 * ks + 8 * kq); }
        u32x4 uzr[8];
        float bsr[8];
#pragma unroll
        for (int pt = 0; pt < 8; ++pt) bsr[pt] = bs[g * 128 + 16 * pt + r16];
        __builtin_amdgcn_sched_barrier(0);
#pragma unroll
        for (int pt = 0; pt < 8; ++pt) uzr[pt] = *(const u32x4*)(UZ + (size_t)(chunk * 128 + 16 * pt + r16) * AW + cw + 8 * kq);
        f32x4 acc[2][8];
#pragma unroll
        for (int ct = 0; ct < 2; ++ct)
#pragma unroll
            for (int pt = 0; pt < 8; ++pt) acc[ct][pt] = (f32x4){0.f, 0.f, 0.f, 0.f};
#pragma unroll
        for (int ks = 0; ks < 4; ++ks) {
            const f32x4 m0 = *(const LAS f32x4*)(smu_i + 32 * ks + 8 * kq), m1 = *(const LAS f32x4*)(smu_i + 32 * ks + 8 * kq + 4);
            const f32x4 r0 = *(const LAS f32x4*)(srs_i + 32 * ks + 8 * kq), r1 = *(const LAS f32x4*)(srs_i + 32 * ks + 8 * kq + 4);
            bf16x8 af[2];
#pragma unroll
            for (int ct = 0; ct < 2; ++ct) { const u32x4 gq = gvr[ct][ks];
                u32x4 w;
                w.x = cvtpk((bflo(gq.x) - m0[0]) * r0[0] * ga[ct] + be[ct], (bfhi(gq.x) - m0[1]) * r0[1] * ga[ct] + be[ct]);
                w.y = cvtpk((bflo(gq.y) - m0[2]) * r0[2] * ga[ct] + be[ct], (bfhi(gq.y) - m0[3]) * r0[3] * ga[ct] + be[ct]);
                w.z = cvtpk((bflo(gq.z) - m1[0]) * r1[0] * ga[ct] + be[ct], (bfhi(gq.z) - m1[1]) * r1[1] * ga[ct] + be[ct]);
                w.w = cvtpk((bflo(gq.w) - m1[2]) * r1[2] * ga[ct] + be[ct], (bfhi(gq.w) - m1[3]) * r1[3] * ga[ct] + be[ct]);
                af[ct] = __builtin_bit_cast(bf16x8, w); }
#pragma unroll
            for (int pt = 0; pt < 8; ++pt) { const bf16x8 bfr = *(const LAS bf16x8*)(Wl + (16 * pt + r16) * 272 + (32 * ks + 8 * kq) * 2);
                acc[0][pt] = __builtin_amdgcn_mfma_f32_16x16x32_bf16(af[0], bfr, acc[0][pt], 0, 0, 0);
                acc[1][pt] = __builtin_amdgcn_mfma_f32_16x16x32_bf16(af[1], bfr, acc[1][pt], 0, 0, 0); }
        }
#pragma unroll
        for (int pt = 0; pt < 8; ++pt) { const int p = 16 * pt + r16; const float bsv = bsr[pt];
            bf16_t* up = UZ + (size_t)(chunk * 128 + p) * AW + cw + 8 * kq;
            const u32x4 uz = uzr[pt]; const f32x4 a0 = acc[0][pt], a1 = acc[1][pt];
            u32x4 w; w.x = cvtpk(bflo(uz.x) * (a0[0] + bsv), bfhi(uz.x) * (a0[1] + bsv)); w.y = cvtpk(bflo(uz.y) * (a0[2] + bsv), bfhi(uz.y) * (a0[3] + bsv));
            w.z = cvtpk(bflo(uz.z) * (a1[0] + bsv), bfhi(uz.z) * (a1[1] + bsv)); w.w = cvtpk(bflo(uz.w) * (a1[2] + bsv), bfhi(uz.w) * (a1[3] + bsv));
            *(u32x4*)up = w; }
    }
}

DI void attn_phase(const Params& P, int j, bool ctxq, LAS unsigned char* lds) {
    const int tid = opaque_tid(), lane = tid & 63, wave = __builtin_amdgcn_readfirstlane(tid >> 6);
    const bf16_t* Q = (const bf16_t*)(P.ws + WS_ACT + ACT_Q); const bf16_t* Kb = (const bf16_t*)(P.ws + WS_ACT + ACT_K);
    const bf16_t* VT = (const bf16_t*)(P.ws + WS_ACT + ACT_VTB); const bf16_t* Z = (const bf16_t*)(P.ws + WS_ACT + ACT_Z); bf16_t* OZ = (bf16_t*)(P.ws + WS_ACT + ACT_OZ);
    const float* sink = P.b_sink + j * 16;
    const int r = lane & 31, h = lane >> 5;
    const int nitems = 1024 + (ctxq ? 64 : 0);
    const int g = wave >> 1, sub = wave & 1;
    constexpr int KP = 144, VP = 136, VOFF = 64 * KP, BUFB = VOFF + 64 * VP;
    const int lrow = tid >> 3, lpc = tid & 7;
    const int kw_off = lrow * KP + lpc * 16, vw_off = VOFF + lrow * VP + lpc * 16;
    const int kfo = r * KP + 16 * h, vfo = VOFF + r * VP + 8 * h;
    const int vcu = (gridDim.x % 8 == 0) ? (int)((blockIdx.x % 8) * (gridDim.x / 8) + blockIdx.x / 8) : (int)blockIdx.x;
    for (int bi = vcu; bi < nitems; bi += gridDim.x) {
        int b, kvh, qrow0, jt_lo, nband, bandrow0, ctxrow0;
        if (bi < 1024) { b = bi >> 8; kvh = (bi >> 6) & 3; const int q64 = bi & 63, qbase = 64 * q64; qrow0 = b * SEQ + qbase + 32 * sub;
            jt_lo = (4 - 2 * q64) > 0 ? (4 - 2 * q64) : 0; const int jt_hi = (131 - 2 * q64) < 9 ? (131 - 2 * q64) : 9; nband = jt_hi - jt_lo + 1; bandrow0 = b * SEQ + qbase - 128; }
        else { const int ci = bi - 1024; b = ci >> 4; kvh = (ci >> 2) & 3; qrow0 = TL + b * CL + 64 * (ci & 3) + 32 * sub; jt_lo = 0; nband = 0; bandrow0 = 0; }
        ctxrow0 = TL + b * CL;
        const int NT = nband + 8, NS = (NT + 1) >> 1;
        const int head = kvh * 4 + g;
        const bf16_t* ksrc = Kb + (size_t)(lrow & 31) * 256 + kvh * 64 + lpc * 8;
        const bf16_t* vsrc = VT + (size_t)(kvh * 64 + lrow) * T + (lpc & 3) * 8;
#define ATT_KROW(i) ((i) < nband ? (bandrow0 + 32 * (jt_lo + (i))) : (ctxrow0 + 32 * ((i) - nband)))
#define ATT_TIDX(st, w) ((2 * (st) + (w)) < NT ? (2 * (st) + (w)) : (NT - 1))
#define ATT_GLOADK(st) (*(const u32x4*)(ksrc + (size_t)ATT_KROW(ATT_TIDX(st, lrow >> 5)) * 256))
#define ATT_GLOADV(st) (*(const u32x4*)(vsrc + (size_t)ATT_KROW(ATT_TIDX(st, lpc >> 2))))
#define ATT_LWRITE(bufi, kv, vv) do { LAS unsigned char* _p = lds + (bufi) * BUFB; *(LAS u32x4*)(_p + kw_off) = (kv); \
            *(LAS u32x2*)(_p + vw_off) = (u32x2){(vv).x, (vv).y}; *(LAS u32x2*)(_p + vw_off + 8) = (u32x2){(vv).z, (vv).w}; } while (0)
        bf16x8 qf[4];
#pragma unroll
        for (int s = 0; s < 4; ++s) qf[s] = *(const bf16x8*)(Q + (size_t)(qrow0 + r) * 1024 + head * 64 + 16 * s + 8 * h);
        const size_t obase = (size_t)(qrow0 + r) * 1024 + head * 64 + 4 * h;
        u32x2 zr[2][4];
#pragma unroll
        for (int g4 = 0; g4 < 4; ++g4) { zr[0][g4] = *(const u32x2*)(Z + obase + 8 * g4); zr[1][g4] = *(const u32x2*)(Z + obase + 32 + 8 * g4); }
        float m_run = sink[head] * LOG2E; float l_part = (h == 0) ? 1.f : 0.f;
        f32x16 o0, o1;
#pragma unroll
        for (int i = 0; i < 16; ++i) { o0[i] = 0.f; o1[i] = 0.f; }
        __syncthreads();
        u32x4 rk[2], rv[2];
        rk[0] = ATT_GLOADK(0); rv[0] = ATT_GLOADV(0); rk[1] = ATT_GLOADK(1); rv[1] = ATT_GLOADV(1);
        ATT_LWRITE(0, rk[0], rv[0]);
        __syncthreads();
        for (int st0 = 0; st0 < NS; st0 += 2) {
#pragma unroll
            for (int u2 = 0; u2 < 2; ++u2) {
                const int st = st0 + u2;
                if (st < NS) {
                    rk[u2] = ATT_GLOADK(st + 2); rv[u2] = ATT_GLOADV(st + 2);
                    const LAS unsigned char* bp = lds + (st & 1) * BUFB;
                    int mode[2];
#pragma unroll
                    for (int w = 0; w < 2; ++w) { const int i = 2 * st + w; const int t = jt_lo + i - sub;
                        mode[w] = (i >= NT) ? 3 : ((i >= nband) ? 0 : ((t < 0 || t > 8) ? 3 : (t == 0 ? 1 : (t == 8 ? 2 : 0)))); }
                    const int mA = __builtin_amdgcn_readfirstlane(mode[0]), mB = __builtin_amdgcn_readfirstlane(mode[1]);
                    if ((mA | mB) != 0) {
                        asm volatile("" ::: "memory");
                    f32x16 S[2];
#pragma unroll
                        for (int w = 0; w < 2; ++w)
#pragma unroll
                            for (int q = 0; q < 16; ++q) S[w][q] = 0.f;
#pragma unroll
                        for (int s = 0; s < 4; ++s) {
                            const bf16x8 ka = *(const LAS bf16x8*)(bp + kfo + 32 * s), kb = *(const LAS bf16x8*)(bp + kfo + 32 * KP + 32 * s);
                            S[0] = __builtin_amdgcn_mfma_f32_32x32x16_bf16(ka, qf[s], S[0], 0, 0, 0); S[1] = __builtin_amdgcn_mfma_f32_32x32x16_bf16(kb, qf[s], S[1], 0, 0, 0); }
                        {
                        const int rr = r - 4 * h;
#pragma unroll
                        for (int w = 0; w < 2; ++w) { const int mw = w ? mB : mA;
                            if (mw == 1) {
#pragma unroll
                                for (int q = 0; q < 16; ++q) { const int c = (q & 3) + 8 * (q >> 2); S[w][q] = (c >= rr) ? S[w][q] : -1e30f; } }
                            else if (mw == 2) {
#pragma unroll
                                for (int q = 0; q < 16; ++q) { const int c = (q & 3) + 8 * (q >> 2); S[w][q] = (c <= rr) ? S[w][q] : -1e30f; } }
                            else if (mw == 3) {
#pragma unroll
                                for (int q = 0; q < 16; ++q) S[w][q] = -1e30f; } }
                        }
                    float mx = max3f(S[0][0], S[1][0], m_run);
#pragma unroll
                        for (int q = 1; q < 16; ++q) mx = max3f(mx, S[0][q], S[1][q]);
                        mx = fmaxf(mx, xhalf_f(mx));
                        if (__builtin_amdgcn_ballot_w64(mx - m_run > 8.0f) != 0ull) { const float alpha = __builtin_amdgcn_exp2f(m_run - mx); l_part *= alpha; m_run = mx;
#pragma unroll
                            for (int q = 0; q < 16; ++q) { o0[q] *= alpha; o1[q] *= alpha; } }
                        f32x2 ps2 = {0.f, 0.f}; const f32x2 mn2 = {m_run, m_run};
#pragma unroll
                        for (int w = 0; w < 2; ++w)
#pragma unroll
                            for (int q = 0; q < 16; q += 2) { const f32x2 d = (f32x2){S[w][q], S[w][q + 1]} - mn2;
                                const f32x2 e = {__builtin_amdgcn_exp2f(d.x), __builtin_amdgcn_exp2f(d.y)}; S[w][q] = e.x; S[w][q + 1] = e.y; ps2 += e; }
                        const float psum = ps2.x + ps2.y;
                        l_part += psum;
#pragma unroll
                        for (int w = 0; w < 2; ++w)
#pragma unroll
                            for (int s = 0; s < 2; ++s) { u32x4 pw; pw.x = cvtpk(S[w][8 * s], S[w][8 * s + 1]); pw.y = cvtpk(S[w][8 * s + 2], S[w][8 * s + 3]); pw.z = cvtpk(S[w][8 * s + 4], S[w][8 * s + 5]); pw.w = cvtpk(S[w][8 * s + 6], S[w][8 * s + 7]);
                                const bf16x8 pf = __builtin_bit_cast(bf16x8, pw);
                                const int vo = vfo + 64 * w + 32 * s;
                                const u32x2 a0 = *(const LAS u32x2*)(bp + vo), a1 = *(const LAS u32x2*)(bp + vo + 16);
                                const u32x2 c0 = *(const LAS u32x2*)(bp + vo + 32 * VP), c1 = *(const LAS u32x2*)(bp + vo + 32 * VP + 16);
                                const bf16x8 va = __builtin_bit_cast(bf16x8, (u32x4){a0.x, a0.y, a1.x, a1.y}), vb = __builtin_bit_cast(bf16x8, (u32x4){c0.x, c0.y, c1.x, c1.y});
                                o0 = __builtin_amdgcn_mfma_f32_32x32x16_bf16(va, pf, o0, 0, 0, 0); o1 = __builtin_amdgcn_mfma_f32_32x32x16_bf16(vb, pf, o1, 0, 0, 0); }
                    } else {
                    f32x16 S[2];
#pragma unroll
                        for (int w = 0; w < 2; ++w)
#pragma unroll
                            for (int q = 0; q < 16; ++q) S[w][q] = 0.f;
#pragma unroll
                        for (int s = 0; s < 4; ++s) {
                            const bf16x8 ka = *(const LAS bf16x8*)(bp + kfo + 32 * s), kb = *(const LAS bf16x8*)(bp + kfo + 32 * KP + 32 * s);
                            S[0] = __builtin_amdgcn_mfma_f32_32x32x16_bf16(ka, qf[s], S[0], 0, 0, 0); S[1] = __builtin_amdgcn_mfma_f32_32x32x16_bf16(kb, qf[s], S[1], 0, 0, 0); }
                    float mx = max3f(S[0][0], S[1][0], m_run);
#pragma unroll
                        for (int q = 1; q < 16; ++q) mx = max3f(mx, S[0][q], S[1][q]);
                        mx = fmaxf(mx, xhalf_f(mx));
                        if (__builtin_amdgcn_ballot_w64(mx - m_run > 8.0f) != 0ull) { const float alpha = __builtin_amdgcn_exp2f(m_run - mx); l_part *= alpha; m_run = mx;
#pragma unroll
                            for (int q = 0; q < 16; ++q) { o0[q] *= alpha; o1[q] *= alpha; } }
                        f32x2 ps2 = {0.f, 0.f}; const f32x2 mn2 = {m_run, m_run};
#pragma unroll
                        for (int w = 0; w < 2; ++w)
#pragma unroll
                            for (int q = 0; q < 16; q += 2) { const f32x2 d = (f32x2){S[w][q], S[w][q + 1]} - mn2;
                                const f32x2 e = {__builtin_amdgcn_exp2f(d.x), __builtin_amdgcn_exp2f(d.y)}; S[w][q] = e.x; S[w][q + 1] = e.y; ps2 += e; }
                        const float psum = ps2.x + ps2.y;
                        l_part += psum;
#pragma unroll
                        for (int w = 0; w < 2; ++w)
#pragma unroll
                            for (int s = 0; s < 2; ++s) { u32x4 pw; pw.x = cvtpk(S[w][8 * s], S[w][8 * s + 1]); pw.y = cvtpk(S[w][8 * s + 2], S[w][8 * s + 3]); pw.z = cvtpk(S[w][8 * s + 4], S[w][8 * s + 5]); pw.w = cvtpk(S[w][8 * s + 6], S[w][8 * s + 7]);
                                const bf16x8 pf = __builtin_bit_cast(bf16x8, pw);
                                const int vo = vfo + 64 * w + 32 * s;
                                const u32x2 a0 = *(const LAS u32x2*)(bp + vo), a1 = *(const LAS u32x2*)(bp + vo + 16);
                                const u32x2 c0 = *(const LAS u32x2*)(bp + vo + 32 * VP), c1 = *(const LAS u32x2*)(bp + vo + 32 * VP + 16);
                                const bf16x8 va = __builtin_bit_cast(bf16x8, (u32x4){a0.x, a0.y, a1.x, a1.y}), vb = __builtin_bit_cast(bf16x8, (u32x4){c0.x, c0.y, c1.x, c1.y});
                                o0 = __builtin_amdgcn_mfma_f32_32x32x16_bf16(va, pf, o0, 0, 0, 0); o1 = __builtin_amdgcn_mfma_f32_32x32x16_bf16(vb, pf, o1, 0, 0, 0); }
                    }
                    ATT_LWRITE((st + 1) & 1, rk[u2 ^ 1], rv[u2 ^ 1]);
                    __syncthreads();
                }
            }
        }
#undef ATT_KROW
#undef ATT_TIDX
#undef ATT_GLOADK
#undef ATT_GLOADV
#undef ATT_LWRITE
        const float l = l_part + __shfl_xor(l_part, 32); const float inv = 1.0f / l;
#pragma unroll
        for (int g4 = 0; g4 < 4; ++g4) {
            { const u32x2 z = zr[0][g4]; u32x2 w;
              w.x = cvtpk(o0[4 * g4] * inv * bflo(z.x), o0[4 * g4 + 1] * inv * bfhi(z.x)); w.y = cvtpk(o0[4 * g4 + 2] * inv * bflo(z.y), o0[4 * g4 + 3] * inv * bfhi(z.y));
              *(u32x2*)(OZ + obase + 8 * g4) = w; }
            { const u32x2 z = zr[1][g4]; u32x2 w;
              w.x = cvtpk(o1[4 * g4] * inv * bflo(z.x), o1[4 * g4 + 1] * inv * bfhi(z.x)); w.y = cvtpk(o1[4 * g4 + 2] * inv * bflo(z.y), o1[4 * g4 + 3] * inv * bfhi(z.y));
              *(u32x2*)(OZ + obase + 32 + 8 * g4) = w; }
        }
    }
}

#define XB_TMO      128
#define XB_XCNT(j)  (256  + 64 * (j))
#define XB_XSUB(j)  (1280 + 64 * (j))
#define XB_XGEN(j)  (2304 + 64 * (j))
#define XB_TOP      3328
#define XB_TOPGEN   3392
#define XCD_BAR_WORDS 3456
#define XB_SPIN_CAP (1u << 18)
DI unsigned xb_ld(unsigned* p)              { return __hip_atomic_load(p, __ATOMIC_RELAXED, __HIP_MEMORY_SCOPE_AGENT); }
DI unsigned xb_add(unsigned* p, unsigned v) { return __hip_atomic_fetch_add(p, v, __ATOMIC_RELAXED, __HIP_MEMORY_SCOPE_AGENT); }
DI unsigned xb_xcc_id() { return (unsigned)__builtin_amdgcn_s_getreg((3 << 11) | 20) & 0xFu; }
#define XB_SPIN(cond, bar) do { unsigned _sp = 0; while (cond) { __builtin_amdgcn_s_sleep(1); \
    if ((++_sp & 255u) == 0u) { if (xb_ld(&(bar)[XB_TMO])) break; if (_sp > XB_SPIN_CAP) { atomicAdd(&(bar)[XB_TMO], 1u); break; } } } } while (0)
struct XcdBarrier { unsigned* bar; unsigned x; volatile LAS unsigned* st; };
DI XcdBarrier xcd_barrier_post(unsigned* bar, volatile LAS unsigned* st) {
    XcdBarrier b; b.bar = bar; b.x = xb_xcc_id(); b.st = st;
    if (threadIdx.x == 0) (void)xb_add(&bar[XB_XCNT(b.x)], 1u);
    return b;
}
DI void xcd_barrier_census_wave(unsigned* bar, unsigned x, volatile LAS unsigned* st) {
    const unsigned G = gridDim.x * gridDim.y * gridDim.z;
    const unsigned lane = threadIdx.x & 63u;
    unsigned c, sum, sp = 0u;
    for (;;) {
        c = lane < 16u ? xb_ld(&bar[XB_XCNT(lane)]) : 0u;
        sum = c;
#pragma unroll
        for (int o = 1; o < 64; o <<= 1) sum += (unsigned)__shfl_xor((int)sum, o);
        if (sum == G) break;
        __builtin_amdgcn_s_sleep(1);
        if ((++sp & 255u) == 0u) { if (xb_ld(&bar[XB_TMO])) break; if (sp > XB_SPIN_CAP) { if (lane == 0u) atomicAdd(&bar[XB_TMO], 1u); break; } }
    }
    const unsigned cnt = (unsigned)__popcll(__builtin_amdgcn_ballot_w64(c > 0u));
    const unsigned mine = (unsigned)__shfl((int)c, (int)x);
    if (lane == 0u) { st[0] = mine > 0u ? mine : 1u; st[1] = cnt > 0u ? cnt : 1u; }
}
DI void xcd_barrier(const XcdBarrier& b) {
    asm volatile("s_waitcnt vmcnt(0)" ::: "memory");
    __syncthreads();
    if (threadIdx.x == 0) {
        unsigned* bar = b.bar;
        __builtin_amdgcn_s_waitcnt(0);
        const unsigned nloc = b.st[0], nx = b.st[1];
        const unsigned old = xb_add(&bar[XB_XSUB(b.x)], 1u);
        const unsigned gen = old / nloc;
        if (old + 1u == (gen + 1u) * nloc) {
            __builtin_amdgcn_fence(__ATOMIC_RELEASE, "agent");
            asm volatile("s_waitcnt vmcnt(0)" ::: "memory");
            const unsigned og = xb_add(&bar[XB_TOP], 1u);
            const unsigned tg = og / nx;
            if (og + 1u == (tg + 1u) * nx) xb_add(&bar[XB_TOPGEN], 1u);
            else XB_SPIN(xb_ld(&bar[XB_TOPGEN]) == tg, bar);
            __builtin_amdgcn_fence(__ATOMIC_ACQUIRE, "agent");
            xb_add(&bar[XB_XGEN(b.x)], 1u);
            asm volatile("s_waitcnt vmcnt(0)" ::: "memory");
        } else {
            XB_SPIN(xb_ld(&bar[XB_XGEN(b.x)]) == gen, bar);
            __builtin_amdgcn_fence(__ATOMIC_ACQUIRE, "agent");
            asm volatile("s_waitcnt vmcnt(0)" ::: "memory");
        }
    }
    __syncthreads();
}

__global__ void __launch_bounds__(NTHREADS, 2) fwd_megakernel(Params P) {
    extern __shared__ __attribute__((aligned(16))) unsigned char lds_raw[];
    LAS unsigned char* lds = (LAS unsigned char*)lds_raw;
    { volatile LAS unsigned* st0 = (volatile LAS unsigned*)(lds + 143360); if (threadIdx.x < 2) st0[threadIdx.x] = 0u; }
    __syncthreads();
    (void)xcd_barrier_post((unsigned*)(P.ws + WS_BAR), (volatile LAS unsigned*)(lds + 143360));
#define GSYNC() do { XcdBarrier xb_; xb_.bar = (unsigned*)(P.ws + WS_BAR); xb_.x = xb_xcc_id(); xb_.st = (volatile LAS unsigned*)(lds + 143360); xcd_barrier(xb_); } while (0)
    unsigned char* ws = P.ws;
    const int G = gridDim.x, cid = blockIdx.x;

#ifndef SKIP_P0
    p0_prologue(P, lds);
#endif
    if (threadIdx.x < 64) xcd_barrier_census_wave((unsigned*)(P.ws + WS_BAR), xb_xcc_id(), (volatile LAS unsigned*)(lds + 143360));
    GSYNC();
#ifndef SKIP_P0B
    p0b_h0(P);
#endif
    GSYNC();

    const bf16_t* H = (const bf16_t*)(ws + WS_H);
    const float* mod = (const float*)(ws + WS_MOD);
#pragma nounroll
    for (int layer = 0; layer < 4; ++layer) {
        const int j = layer >> 1;
        EpiG2 E2; E2.x0 = layer == 0 ? P.x : nullptr; E2.rsrc = (const unsigned short*)P.out; E2.rdst = layer == 3 ? (unsigned short*)(ws + WS_H) : (unsigned short*)P.out;
        E2.xc0 = layer == 0 ? P.ctx : nullptr; E2.rc = (unsigned short*)(ws + WS_XC); E2.gate = mod + layer * 15360 + 2048;
        E2.rstat = (const float*)(ws + WS_RSTAT); E2.png = P.ln_g + (layer > 0 ? layer - 1 : 0) * DM; E2.pnb = P.ln_b + (layer > 0 ? layer - 1 : 0) * DM;
        const int nM2 = 64;
        if ((layer & 1) == 0) {
            unsigned char* wa = ws + WS_WA0 + (size_t)j * WA_SIZE;
            { pg8::VSched S; S.init(68, 24, 16, G, cid, H, wa + WA_UZ, wa + WA_V, 1024);
              EpiG1A E; E.UZ = (bf16_t*)(ws + WS_ACT + ACT_UZ); E.VT = (bf16_t*)(ws + WS_ACT + ACT_VTA); E.stat = (float*)(ws + WS_STAT);
#ifndef SKIP_G1A
              { int nrep = REPN_G1A; asm volatile("" : "+s"(nrep));
#pragma nounroll
                for (int rep = 0; rep < nrep; ++rep) pg8::gemm_phase<EpiG1A, true, true>(lds, 1024, S, E); }
#endif
            }
            GSYNC();
#ifndef SKIP_SM
            spatial_mix(P, j, lds);
#endif
            GSYNC();
            { pg8::VSched S; S.init(nM2, 4, 4, G, cid, ws + WS_ACT + ACT_UZ, wa + WA_OUT, nullptr, 2048);
#ifndef SKIP_G2
              pg8::gemm_phase<EpiG2, true, true>(lds, 2048, S, E2);
#endif
            }
            if (layer < 3) g2_ctx_small(P, lds, (const bf16_t*)(ws + WS_ACT + ACT_UZ) + (size_t)TL * 2048, (const bf16_t*)(wa + WA_OUT), 2048, E2);
            GSYNC();
        } else {
            unsigned char* wb = ws + WS_WB0 + (size_t)j * WB_SIZE;
            { pg8::VSched S; S.init(68, 10, 9, G, cid, H, wb + WB_QKZ, wb + WB_V, 1024);
              EpiG1B E; E.Q = (bf16_t*)(ws + WS_ACT + ACT_Q); E.Kb = (bf16_t*)(ws + WS_ACT + ACT_K); E.Z = (bf16_t*)(ws + WS_ACT + ACT_Z); E.VT = (bf16_t*)(ws + WS_ACT + ACT_VTB); E.rope = (const LAS float*)(lds + 131072);
              { const int ct = opaque_tid(); *(LAS u32x4*)(lds + 131072 + ct * 16) = *(const u32x4*)(ws + WS_ROPE + ct * 16); __syncthreads(); }
#ifndef SKIP_G1B
              { int nrep = REPN_G1B; asm volatile("" : "+s"(nrep));
#pragma nounroll
                for (int rep = 0; rep < nrep; ++rep) pg8::gemm_phase<EpiG1B, true, true>(lds, 1024, S, E); }
#endif
            }
            GSYNC();
#ifndef SKIP_ATT
            attn_phase(P, j, layer < 3, lds);
#ifdef REP_ATT
            attn_phase(P, j, layer < 3, lds);
#endif
#endif
            GSYNC();
            { pg8::VSched S; S.init(nM2, 4, 4, G, cid, ws + WS_ACT + ACT_OZ, wb + WB_OUT, nullptr, 1024);
#ifndef SKIP_G2
              pg8::gemm_phase<EpiG2, true, true>(lds, 1024, S, E2);
#endif
            }
            if (layer < 3) g2_ctx_small(P, lds, (const bf16_t*)(ws + WS_ACT + ACT_OZ) + (size_t)TL * 1024, (const bf16_t*)(wb + WB_OUT), 1024, E2);
            GSYNC();
        }
#ifndef SKIP_LN
        ln_phase(P, layer);
#endif
        if (layer < 3) GSYNC();
#ifdef REP_SYNC
        GSYNC(); GSYNC(); GSYNC(); GSYNC();
#endif
    }
}

extern "C" void kernel_launch(void* const* d_in, const int* in_sizes, int n_in, void* d_out, int out_size, void* d_ws, size_t ws_size, hipStream_t stream) {
    static int grid = 0;
    if (grid == 0) {
        if (n_in != 17 || out_size != TL * DM || ws_size < WS_END) { fprintf(stderr, "kernel_launch: unexpected shapes (n_in %d out %d ws %zu)\n", n_in, out_size, ws_size); grid = -1; return; }
        int dev = 0, cus = 0, per_cu = 0;
        hipGetDevice(&dev);
        hipDeviceGetAttribute(&cus, hipDeviceAttributeMultiprocessorCount, dev);
        hipFuncSetAttribute((const void*)fwd_megakernel, hipFuncAttributeMaxDynamicSharedMemorySize, LDS_BYTES);
        hipOccupancyMaxActiveBlocksPerMultiprocessor(&per_cu, (const void*)fwd_megakernel, NTHREADS, LDS_BYTES);
        if (per_cu < 1) { fprintf(stderr, "kernel_launch: occupancy query says %d blocks/CU\n", per_cu); per_cu = 1; }
        grid = cus * per_cu;
        fprintf(stderr, "kernel_launch: cus %d per_cu %d grid %d\n", cus, per_cu, grid);
    }
    if (grid < 0) return;
    Params p{};
    p.x = (const float*)d_in[0]; p.c = (const float*)d_in[1]; p.ctx = (const float*)d_in[2]; p.c_ctx = (const float*)d_in[3];
    p.ada_w = (const float*)d_in[4]; p.ada_b = (const float*)d_in[5]; p.ln_g = (const float*)d_in[6]; p.ln_b = (const float*)d_in[7];
    p.a_w_in = (const float*)d_in[8]; p.a_ln_g = (const float*)d_in[9]; p.a_ln_b = (const float*)d_in[10]; p.a_w_s = (const float*)d_in[11]; p.a_b_s = (const float*)d_in[12]; p.a_w_out = (const float*)d_in[13];
    p.b_w_in = (const float*)d_in[14]; p.b_sink = (const float*)d_in[15]; p.b_w_out = (const float*)d_in[16];
    p.out = (float*)d_out; p.ws = (unsigned char*)d_ws;
    (void)hipMemsetAsync((char*)d_ws + WS_BAR, 0, XCD_BAR_WORDS * 4, stream);
    void* args[] = {&p};
    hipError_t e = hipLaunchCooperativeKernel((const void*)fwd_megakernel, dim3(grid), dim3(NTHREADS), args, LDS_BYTES, stream);
    if (e != hipSuccess) fprintf(stderr, "cooperative launch failed: %s (grid %d)\n", hipGetErrorString(e), grid);
}
```

```cpp
#include <hip/hip_runtime.h>
#include <cstdio>
#include <cstdint>
#ifndef REPN_G1A
#define REPN_G1A 1
#endif
#ifndef REPN_G1B
#define REPN_G1B 1
#endif

#define LAS __attribute__((address_space(3)))
#define DI __device__ __forceinline__
typedef unsigned short bf16_t;
typedef short bf16x8 __attribute__((ext_vector_type(8)));
typedef short s16x4 __attribute__((ext_vector_type(4)));
typedef float f32x2 __attribute__((ext_vector_type(2)));
typedef float f32x4 __attribute__((ext_vector_type(4)));
typedef float f32x16 __attribute__((ext_vector_type(16)));
typedef unsigned u32x2 __attribute__((ext_vector_type(2)));
typedef unsigned u32x4 __attribute__((ext_vector_type(4)));
typedef __bf16 bf16x2_t __attribute__((ext_vector_type(2)));

constexpr int DM = 1024, NB = 4, SEQ = 4096, TL = NB * SEQ, CL = 256, TC = NB * CL, T = TL + TC;
constexpr int AW = 2048;
constexpr float LN_EPS = 1e-5f;
constexpr float ALPHA = 1.681792830507429f;
constexpr float LOG2E = 1.4426950408889634f;
constexpr int NTHREADS = 512, NWAVES = 8;
constexpr int LDS_BYTES = 147456;

constexpr size_t MiB = 1u << 20;
constexpr size_t WS_MOD = 0;
constexpr size_t WS_ROPE = 262144;
constexpr size_t WS_STAT = 524288;
constexpr size_t WS_BAR = 2883584;
constexpr size_t WS_RSTAT = WS_BAR + 16384;
constexpr size_t WS_XC = 3 * MiB;
constexpr size_t WS_W = 7 * MiB;
constexpr size_t WA_UZ = 0, WA_V = 8 * MiB, WA_OUT = 12 * MiB, WA_S = 16 * MiB, WA_SIZE = 16 * MiB + 262144;
constexpr size_t WB_QKZ = 0, WB_V = 4 * MiB + 524288, WB_OUT = 5 * MiB, WB_SIZE = 7 * MiB;
constexpr size_t WS_WA0 = WS_W, WS_WB0 = WS_W + 2 * WA_SIZE;
constexpr size_t WS_H = 54 * MiB;
constexpr size_t WS_ACT = 88 * MiB;
constexpr size_t ACT_UZ = 0, ACT_VTA = 68 * MiB;
constexpr size_t ACT_Q = 0, ACT_K = 34 * MiB, ACT_VTB = 34 * MiB + 8912896, ACT_Z = 52 * MiB, ACT_OZ = 86 * MiB;
constexpr size_t WS_END = 224 * MiB;
static_assert(WS_WB0 + 2 * WB_SIZE <= WS_H, "weights fit");
static_assert((size_t)T * 256 * 2 == 8912896, "kv size");
static_assert(ACT_VTB + 8912896 <= ACT_Z && ACT_OZ + 34 * MiB <= 136 * MiB, "act map");

DI unsigned cvtpk(float lo, float hi) { f32x2 v = {lo, hi}; bf16x2_t b = __builtin_convertvector(v, bf16x2_t); return __builtin_bit_cast(unsigned, b); }
DI float bflo(unsigned u) { return __uint_as_float(u << 16); }
DI float bfhi(unsigned u) { return __uint_as_float(u & 0xffff0000u); }
DI float fast_sigmoid(float t) { return __builtin_amdgcn_rcpf(1.0f + __builtin_amdgcn_exp2f(-LOG2E * t)); }
DI float gelu_t(float x) { const float t = x * (1.5957691216057308f + 0.07135481627183409f * x * x); return x * fast_sigmoid(t); }
DI float silu_f(float x) { return x * fast_sigmoid(x); }
typedef _Float16 h16x2 __attribute__((ext_vector_type(2)));
DI unsigned pkh(float lo, float hi) { const h16x2 v = {(_Float16)lo, (_Float16)hi}; return __builtin_bit_cast(unsigned, v); }
DI float hlo(unsigned u) { return (float)__builtin_bit_cast(h16x2, u).x; }
DI float hhi(unsigned u) { return (float)__builtin_bit_cast(h16x2, u).y; }
DI int opaque_tid() { int t = threadIdx.x; asm volatile("" : "+v"(t)); return t; }
template <int CTRL> DI float dpp_add(float v) { return v + __builtin_bit_cast(float, __builtin_amdgcn_update_dpp(0, __builtin_bit_cast(int, v), CTRL, 0xf, 0xf, false)); }
DI float max3f(float a, float b, float c) { float r; asm("v_max3_f32 %0, %1, %2, %3" : "=v"(r) : "v"(a), "v"(b), "v"(c)); return r; }
DI f32x2 exp2_2(f32x2 v) { return (f32x2){__builtin_amdgcn_exp2f(v.x), __builtin_amdgcn_exp2f(v.y)}; }
DI f32x2 rcp_2(f32x2 v) { return (f32x2){__builtin_amdgcn_rcpf(v.x), __builtin_amdgcn_rcpf(v.y)}; }
constexpr float GELU_A = -1.5957691216057308f * LOG2E, GELU_B = -0.07135481627183409f * LOG2E;
DI f32x2 gelu_silu_pk(f32x2 u, f32x2 z) { const f32x2 p = (u * u) * GELU_B + GELU_A; const f32x2 e1 = exp2_2(u * p), e2 = exp2_2(z * (-LOG2E)); return (u * z) * rcp_2((e1 + 1.0f) * (e2 + 1.0f)); }
DI f32x2 gelu_pk2(f32x2 u) { const f32x2 p = (u * u) * GELU_B + GELU_A; return u * rcp_2(exp2_2(u * p) + 1.0f); }
DI f32x2 silu_pk2(f32x2 z) { return z * rcp_2(exp2_2(z * (-LOG2E)) + 1.0f); }
DI float xhalf_f(float v) { const unsigned u = __builtin_bit_cast(unsigned, v);
#if __has_builtin(__builtin_amdgcn_permlane32_swap)
    const auto r = __builtin_amdgcn_permlane32_swap(u, u, false, false); const unsigned lo = r[0], hi = r[1];
    return __builtin_bit_cast(float, (threadIdx.x & 32) ? lo : hi);
#else
    return __shfl_xor(v, 32);
#endif
}
DI float wave_sum_dpp(float v) {
    v = dpp_add<0xB1>(v); v = dpp_add<0x4E>(v); v = dpp_add<0x141>(v); v = dpp_add<0x140>(v);
    v += __shfl_xor(v, 16); v += __shfl_xor(v, 32);
    return v;
}
DI float wave_sum(float v) {
#pragma unroll
    for (int o = 1; o < 64; o <<= 1) v += __shfl_xor(v, o);
    return v;
}

namespace pg8 {
#define PG8_LAS __attribute__((address_space(3)))
constexpr int BM = 256, BK = 64, HALF = 128, HTB = HALF * BK * 2, STAGE_BYTES = 8 * HTB, NXCD = 8, WGM = 8;
__host__ __device__ __forceinline__ int lds_byte(int r, int c) { const int st = (r >> 4) * 2 + (c >> 5), rr = r & 15, cc = c & 31, ob = rr * 64 + cc * 2; return st * 1024 + (ob ^ (((ob >> 9) & 1) << 5)); }
__host__ __device__ __forceinline__ void stage_rc(int b, int& R, int& C) { const int st = b / 1024, sb = b % 1024, swz = sb ^ (((sb >> 9) & 1) << 5); R = (st >> 1) * 16 + swz / 64; C = (st & 1) * 32 + (swz % 64) / 2; }
__host__ __device__ __forceinline__ int perm32(int rho) { const int n = rho >> 4, i = rho & 15; return 8 * (i >> 2) + 4 * n + (i & 3); }

struct Unit { int pm, pn; };

struct VSched {
    int nM, nN, nwg, G, c, nsplit; const char* A0; const char* B0; const char* A1; size_t tstep;
    DI void init(int nM_, int nN_, int nsplit_, int G_, int c_, const void* a0, const void* b0, const void* a1, int K) {
        nM = nM_; nN = nN_; nwg = nM * nN; G = G_; c = c_; nsplit = nsplit_; A0 = (const char*)a0; B0 = (const char*)b0; A1 = (const char*)a1; tstep = (size_t)BM * K * 2; }
    DI bool next(int i, Unit& u) const {
        const long L = (long)i * G + c; if (L >= nwg) return false;
        int wgid = (int)L; { const int q = nwg / NXCD, r = nwg % NXCD, xcd = wgid % NXCD, off = wgid / NXCD; wgid = (xcd < r ? xcd * (q + 1) : r * (q + 1) + (xcd - r) * q) + off; }
        const int nig = WGM * nN, gid = wgid / nig, fm = gid * WGM, gsz = (nM - fm) < WGM ? (nM - fm) : WGM;
        u.pm = fm + ((wgid % nig) % gsz); u.pn = (wgid % nig) / gsz; return true;
    }
    DI const char* pa(const Unit& u) const { return u.pn < nsplit ? A0 + (size_t)u.pm * tstep : A1 + (size_t)(u.pn - nsplit) * tstep; }
    DI const char* pb(const Unit& u) const { return u.pn < nsplit ? B0 + (size_t)u.pn * tstep : A0 + (size_t)u.pm * tstep; }
};

template <class Epi, bool ALIGN_EPI, bool SP2>
__device__ __forceinline__ void gemm_phase(PG8_LAS unsigned char* lds, const int K, const VSched& S, const Epi& E) {
    const int tid = opaque_tid(), wid = __builtin_amdgcn_readfirstlane(tid >> 6), lane = tid & 63, wr = wid >> 2, wc = wid & 3, fr = lane & 15, fq = lane >> 4;
    const int nt = K / BK;
    unsigned voffA[2], voffB[2];
#pragma unroll
    for (int i = 0; i < 2; ++i) { int R, C; stage_rc(tid * 16 + i * 8192, R, C); const int Rb = Epi::PERM ? ((R & ~31) + perm32(R & 31)) : R;
        voffA[i] = (unsigned)(R * K + C) * 2u; voffB[i] = (unsigned)(Rb * K + C) * 2u; }
    const size_t kstep = (size_t)(BK * 2);
    const size_t hstep = (size_t)HALF * K * 2;
    const unsigned ldsw = (unsigned)wid * 1024u;
    const int aoff = lds_byte(wr * 64 + fr, fq * 8), boff = lds_byte(wc * 32 + fr, fq * 8);
#define PG8_SA(b, h) (((b) * 2 + (h)) * HTB)
#define PG8_SB(b, h) ((4 + (b) * 2 + (h)) * HTB)
#define PG8_STAGE(bufoff, gbase, voff) do { _Pragma("unroll") for (int _i = 0; _i < 2; ++_i) \
        __builtin_amdgcn_global_load_lds((const unsigned*)((const char*)(gbase) + (voff)[_i]), (PG8_LAS unsigned*)(lds + (bufoff) + ldsw + _i * 8192), 16, 0, 0); } while (0)
#define PG8_LDA(dst, b, h) do { _Pragma("unroll") for (int m = 0; m < 4; ++m) _Pragma("unroll") for (int k = 0; k < 2; ++k) dst[m][k] = *(const PG8_LAS bf16x8*)(lds + PG8_SA(b, h) + aoff + m * 2048 + k * 1024); } while (0)
#define PG8_LDB(dst, b, h) do { _Pragma("unroll") for (int n = 0; n < 2; ++n) _Pragma("unroll") for (int k = 0; k < 2; ++k) dst[n][k] = *(const PG8_LAS bf16x8*)(lds + PG8_SB(b, h) + boff + n * 2048 + k * 1024); } while (0)
#define PG8_MMA(ai, bj, At, Bt) do { __builtin_amdgcn_s_setprio(1); _Pragma("unroll") for (int m = 0; m < 4; ++m) _Pragma("unroll") for (int n = 0; n < 2; ++n) _Pragma("unroll") for (int k = 0; k < 2; ++k) \
        acc[ai][bj][m][n] = __builtin_amdgcn_mfma_f32_16x16x32_bf16(Bt[n][k], At[m][k], acc[ai][bj][m][n], 0, 0, 0); __builtin_amdgcn_s_setprio(0); } while (0)
#define PG8_WAIT_V(n) asm volatile("s_waitcnt vmcnt(" #n ")" ::: "memory")
#define PG8_WAIT_L(n) asm volatile("s_waitcnt lgkmcnt(" #n ")" ::: "memory")
#define PG8_BAR __builtin_amdgcn_s_barrier()
#define PG8_SCHED __builtin_amdgcn_sched_barrier(0)
    Unit cur, nxt; int ui = 0;
    if (!S.next(0, cur)) return;
    f32x4 acc[2][2][4][2];
#pragma unroll
    for (int a = 0; a < 2; ++a)
#pragma unroll
        for (int b = 0; b < 2; ++b)
#pragma unroll
            for (int m = 0; m < 4; ++m)
#pragma unroll
                for (int n = 0; n < 2; ++n) acc[a][b][m][n] = (f32x4){0.f, 0.f, 0.f, 0.f};
    bf16x8 At[4][2], B0[2][2], B1[2][2];
    const char* cA = S.pa(cur); const char* cB = S.pb(cur);
    if constexpr (SP2) {
        PG8_STAGE(PG8_SB(0, 0), cB, voffB); PG8_STAGE(PG8_SB(0, 1), cB + hstep, voffB); PG8_STAGE(PG8_SA(0, 0), cA, voffA); PG8_STAGE(PG8_SA(0, 1), cA + hstep, voffA);
        if (wr == 1) PG8_BAR;
        PG8_WAIT_V(2); PG8_BAR;
        PG8_STAGE(PG8_SB(1, 0), cB + kstep, voffB); PG8_STAGE(PG8_SA(1, 0), cA + kstep, voffA); PG8_STAGE(PG8_SB(1, 1), cB + hstep + kstep, voffB);
        PG8_WAIT_V(6); PG8_BAR;
    } else {
        PG8_STAGE(PG8_SB(0, 0), cB, voffB); PG8_STAGE(PG8_SA(0, 0), cA, voffA); PG8_STAGE(PG8_SB(0, 1), cB + hstep, voffB); PG8_STAGE(PG8_SA(0, 1), cA + hstep, voffA);
        if (wr == 1) PG8_BAR;
        PG8_WAIT_V(4); PG8_BAR;
        PG8_STAGE(PG8_SB(1, 0), cB + kstep, voffB); PG8_STAGE(PG8_SA(1, 0), cA + kstep, voffA); PG8_STAGE(PG8_SB(1, 1), cB + hstep + kstep, voffB);
        PG8_WAIT_V(6); PG8_BAR;
    }
    for (;;) {
        const bool has_next = S.next(ui + 1, nxt);
        const char* nA = has_next ? S.pa(nxt) : cA; const char* nB = has_next ? S.pb(nxt) : cB;
        for (int t = 0; t < nt; t += 2) {
            const bool last = (t == nt - 2);
            const char* a1 = cA + (size_t)(t + 1) * kstep;
            const char* a2 = last ? nA : cA + (size_t)(t + 2) * kstep; const char* b2 = last ? nB : cB + (size_t)(t + 2) * kstep;
            const char* a3 = a2 + kstep; const char* b3 = b2 + kstep;
            if constexpr (SP2) {
            PG8_LDB(B0, 0, 0); PG8_LDB(B1, 0, 1); PG8_SCHED; PG8_LDA(At, 0, 0); PG8_STAGE(PG8_SA(1, 1), a1 + hstep, voffA);
            PG8_WAIT_V(8); PG8_WAIT_L(0); PG8_BAR; PG8_MMA(0, 0, At, B0); PG8_MMA(0, 1, At, B1); PG8_BAR; PG8_SCHED;
            PG8_LDA(At, 0, 1); PG8_STAGE(PG8_SB(0, 0), b2, voffB); PG8_STAGE(PG8_SB(0, 1), b2 + hstep, voffB); PG8_STAGE(PG8_SA(0, 0), a2, voffA);
            PG8_WAIT_V(8); PG8_WAIT_L(0); PG8_BAR; PG8_MMA(1, 0, At, B0); PG8_MMA(1, 1, At, B1); PG8_BAR; PG8_SCHED;
            PG8_LDB(B0, 1, 0); PG8_LDB(B1, 1, 1); PG8_SCHED; PG8_LDA(At, 1, 0); PG8_STAGE(PG8_SA(0, 1), a2 + hstep, voffA);
            PG8_WAIT_V(8); PG8_WAIT_L(0); PG8_BAR; PG8_MMA(0, 0, At, B0); PG8_MMA(0, 1, At, B1); PG8_BAR; PG8_SCHED;
            PG8_LDA(At, 1, 1); PG8_STAGE(PG8_SB(1, 0), b3, voffB); PG8_STAGE(PG8_SB(1, 1), b3 + hstep, voffB); PG8_STAGE(PG8_SA(1, 0), a3, voffA);
            PG8_WAIT_V(8); PG8_WAIT_L(0); PG8_BAR; PG8_MMA(1, 0, At, B0); PG8_MMA(1, 1, At, B1); PG8_BAR; PG8_SCHED;
            } else {
            PG8_LDB(B0, 0, 0); PG8_SCHED; PG8_LDA(At, 0, 0); PG8_STAGE(PG8_SA(1, 1), a1 + hstep, voffA);
            PG8_WAIT_L(8); PG8_BAR; PG8_WAIT_L(0); PG8_MMA(0, 0, At, B0); PG8_BAR; PG8_SCHED;
            PG8_LDB(B1, 0, 1); PG8_STAGE(PG8_SB(0, 0), b2, voffB);
            PG8_BAR; PG8_WAIT_L(0); PG8_MMA(0, 1, At, B1); PG8_BAR;
            PG8_LDA(At, 0, 1); PG8_STAGE(PG8_SA(0, 0), a2, voffA);
            PG8_BAR; PG8_WAIT_L(0); PG8_MMA(1, 0, At, B0); PG8_BAR; PG8_SCHED;
            PG8_STAGE(PG8_SB(0, 1), b2 + hstep, voffB);
            PG8_WAIT_V(6); PG8_BAR; PG8_MMA(1, 1, At, B1); PG8_BAR;
            PG8_LDB(B0, 1, 0); PG8_SCHED; PG8_LDA(At, 1, 0); PG8_STAGE(PG8_SA(0, 1), a2 + hstep, voffA);
            PG8_WAIT_L(8); PG8_BAR; PG8_WAIT_L(0); PG8_MMA(0, 0, At, B0); PG8_BAR; PG8_SCHED;
            PG8_LDB(B1, 1, 1); PG8_STAGE(PG8_SB(1, 0), b3, voffB);
            PG8_BAR; PG8_WAIT_L(0); PG8_MMA(0, 1, At, B1); PG8_BAR;
            PG8_LDA(At, 1, 1); PG8_STAGE(PG8_SA(1, 0), a3, voffA);
            PG8_BAR; PG8_WAIT_L(0); PG8_MMA(1, 0, At, B0); PG8_BAR; PG8_SCHED;
            PG8_STAGE(PG8_SB(1, 1), b3 + hstep, voffB);
            PG8_WAIT_V(6); PG8_BAR; PG8_MMA(1, 1, At, B1); PG8_BAR;
            }
        }
        if constexpr (ALIGN_EPI) { if (wr == 0) PG8_BAR; }
        { int fr2 = fr, fq2 = fq; asm volatile("" : "+v"(fr2), "+v"(fq2)); E(acc, cur, wr, wc, fr2, fq2); }
        if (!has_next) break;
#pragma unroll
        for (int a = 0; a < 2; ++a)
#pragma unroll
            for (int b = 0; b < 2; ++b)
#pragma unroll
                for (int m = 0; m < 4; ++m)
#pragma unroll
                    for (int n = 0; n < 2; ++n) acc[a][b][m][n] = (f32x4){0.f, 0.f, 0.f, 0.f};
        cur = nxt; cA = nA; cB = nB; ++ui;
        if constexpr (ALIGN_EPI) { if (wr == 1) PG8_BAR; }
    }
    PG8_WAIT_V(0);
    if constexpr (!ALIGN_EPI) { if (wr == 0) PG8_BAR; }
    PG8_BAR;
#undef PG8_SA
#undef PG8_SB
#undef PG8_STAGE
#undef PG8_LDA
#undef PG8_LDB
#undef PG8_MMA
#undef PG8_WAIT_V
#undef PG8_WAIT_L
#undef PG8_BAR
#undef PG8_SCHED
}
}
using pg8::Unit;

struct EpiG1A {
    static constexpr bool PERM = true;
    bf16_t* UZ; bf16_t* VT; float* stat;
    DI void operator()(const f32x4 (&acc)[2][2][4][2], const Unit& u, int wr, int wc, int fr, int fq) const {
        if (u.pn < 16) {
#ifndef NO_UZ
            const int row0 = u.pm * 256 + wr * 64 + fr, col0 = u.pn * 128 + wc * 32 + 8 * fq;
#pragma unroll
            for (int ai = 0; ai < 2; ++ai)
#pragma unroll
                for (int m = 0; m < 4; ++m) {
                    const f32x4 u0 = acc[ai][0][m][0], u1 = acc[ai][0][m][1], z0 = acc[ai][1][m][0], z1 = acc[ai][1][m][1];
                    const f32x2 oa = gelu_silu_pk((f32x2){u0[0], u0[1]}, (f32x2){z0[0], z0[1]}), ob = gelu_silu_pk((f32x2){u0[2], u0[3]}, (f32x2){z0[2], z0[3]});
                    const f32x2 oc = gelu_silu_pk((f32x2){u1[0], u1[1]}, (f32x2){z1[0], z1[1]}), od = gelu_silu_pk((f32x2){u1[2], u1[3]}, (f32x2){z1[2], z1[3]});
                    u32x4 w; w.x = cvtpk(oa.x, oa.y); w.y = cvtpk(ob.x, ob.y); w.z = cvtpk(oc.x, oc.y); w.w = cvtpk(od.x, od.y);
                    *(u32x4*)(UZ + (size_t)(row0 + ai * 128 + m * 16) * AW + col0) = w;
                }
#endif
        } else {
#ifndef NO_VT
            const int ct = u.pn - 16;
            const int ch0 = ct * 256 + wr * 64 + fr, tok0 = u.pm * 256 + wc * 32 + 8 * fq;
            float one = 1.0f; asm volatile("" : "+v"(one));
#pragma unroll
            for (int bj = 0; bj < 2; ++bj) {
                float s1[8], s2[8];
#pragma unroll
                for (int t = 0; t < 8; ++t) { s1[t] = 0.f; s2[t] = 0.f; }
#pragma unroll
                for (int ai = 0; ai < 2; ++ai)
#pragma unroll
                    for (int m = 0; m < 4; ++m) {
                        float g[8];
#pragma unroll
                        for (int j = 0; j < 4; ++j) { g[j] = gelu_t(acc[ai][bj][m][0][j] * one); g[4 + j] = gelu_t(acc[ai][bj][m][1][j] * one); }
#pragma unroll
                        for (int j = 0; j < 8; ++j) { s1[j] += g[j]; s2[j] += g[j] * g[j]; }
                        u32x4 w; w.x = cvtpk(g[0], g[1]); w.y = cvtpk(g[2], g[3]); w.z = cvtpk(g[4], g[5]); w.w = cvtpk(g[6], g[7]);
                        *(u32x4*)(VT + (size_t)(ch0 + ai * 128 + m * 16) * T + tok0 + bj * 128) = w;
                    }
#pragma unroll
                for (int k = 0; k < 8; ++k) {
                    s1[k] = dpp_add<0xB1>(s1[k]); s2[k] = dpp_add<0xB1>(s2[k]);
                    s1[k] = dpp_add<0x4E>(s1[k]); s2[k] = dpp_add<0x4E>(s2[k]);
                    s1[k] = dpp_add<0x141>(s1[k]); s2[k] = dpp_add<0x141>(s2[k]);
                    s1[k] = dpp_add<0x140>(s1[k]); s2[k] = dpp_add<0x140>(s2[k]); }
#pragma unroll
                for (int k = 1; k < 8; ++k) { s1[0] = (fr == k) ? s1[k] : s1[0]; s2[0] = (fr == k) ? s2[k] : s2[0]; }
                if (fr < 8) { const int tok = tok0 + bj * 128 + fr;
                    *(f32x2*)(stat + ((size_t)tok * 16 + ct * 2 + wr) * 2) = (f32x2){s1[0], s2[0]}; }
            }
#endif
        }
    }
};

struct EpiG1B {
    static constexpr bool PERM = true;
    bf16_t* Q; bf16_t* Kb; bf16_t* Z; bf16_t* VT; const LAS float* rope;
    DI void operator()(const f32x4 (&acc)[2][2][4][2], const Unit& u, int wr, int wc, int fr, int fq) const {
        if (u.pn <= 4) {
            const bool isq = u.pn < 4, latent = u.pm < 64;
            const float sc = isq ? 0.125f * LOG2E : 1.0f;
            const int axis = wc & 1, f0 = 8 * (fq & 1);
            const float sgn = (fq < 2) ? -1.f : 1.f;
            bf16_t* base = isq ? Q + u.pn * 256 : Kb; const int ld = isq ? 1024 : 256;
#pragma unroll
            for (int ai = 0; ai < 2; ++ai)
#pragma unroll
                for (int m = 0; m < 4; ++m) {
                    const int row = u.pm * 256 + ai * 128 + wr * 64 + m * 16 + fr;
                    const int t = row & 4095, pos = axis ? (t & 63) : (t >> 6);
                    f32x4 c0 = {1.f, 1.f, 1.f, 1.f}, c1 = c0, s0 = {0.f, 0.f, 0.f, 0.f}, s1 = s0;
                    if (latent) { const LAS float* cp = rope + pos * 16 + f0; c0 = *(const LAS f32x4*)cp; c1 = *(const LAS f32x4*)(cp + 4); s0 = *(const LAS f32x4*)(cp + 1024); s1 = *(const LAS f32x4*)(cp + 1028); }
#pragma unroll
                    for (int bj = 0; bj < 2; ++bj) {
                        const f32x4 v0 = acc[ai][bj][m][0], v1 = acc[ai][bj][m][1];
                        float o[8];
#pragma unroll
                        for (int j = 0; j < 4; ++j) {
                            const float p0 = __shfl_xor(v0[j], 32), p1 = __shfl_xor(v1[j], 32);
                            o[j] = (v0[j] * c0[j] + sgn * p0 * s0[j]) * sc; o[4 + j] = (v1[j] * c1[j] + sgn * p1 * s1[j]) * sc; }
                        u32x4 w; w.x = cvtpk(o[0], o[1]); w.y = cvtpk(o[2], o[3]); w.z = cvtpk(o[4], o[5]); w.w = cvtpk(o[6], o[7]);
                        *(u32x4*)(base + (size_t)row * ld + bj * 128 + wc * 32 + 8 * fq) = w;
                    }
                }
        } else if (u.pn < 9) {
            bf16_t* base = Z + (u.pn - 5) * 256 + wc * 32 + 8 * fq;
#pragma unroll
            for (int ai = 0; ai < 2; ++ai)
#pragma unroll
                for (int m = 0; m < 4; ++m) {
                    const int row = u.pm * 256 + ai * 128 + wr * 64 + m * 16 + fr;
#pragma unroll
                    for (int bj = 0; bj < 2; ++bj) {
                        const f32x4 v0 = acc[ai][bj][m][0], v1 = acc[ai][bj][m][1];
                        const f32x2 sa = silu_pk2((f32x2){v0[0], v0[1]}), sb = silu_pk2((f32x2){v0[2], v0[3]}), sc2 = silu_pk2((f32x2){v1[0], v1[1]}), sd = silu_pk2((f32x2){v1[2], v1[3]});
                        u32x4 w; w.x = cvtpk(sa.x, sa.y); w.y = cvtpk(sb.x, sb.y); w.z = cvtpk(sc2.x, sc2.y); w.w = cvtpk(sd.x, sd.y);
                        *(u32x4*)(base + (size_t)row * 1024 + bj * 128) = w;
                    }
                }
        } else {
            const int tok0 = u.pm * 256 + wc * 32 + 8 * fq;
#pragma unroll
            for (int ai = 0; ai < 2; ++ai)
#pragma unroll
                for (int m = 0; m < 4; ++m) {
                    const int ch = ai * 128 + wr * 64 + m * 16 + fr;
#pragma unroll
                    for (int bj = 0; bj < 2; ++bj) {
                        const f32x4 v0 = acc[ai][bj][m][0], v1 = acc[ai][bj][m][1];
                        u32x4 w; w.x = cvtpk(v0[0], v0[1]); w.y = cvtpk(v0[2], v0[3]); w.z = cvtpk(v1[0], v1[1]); w.w = cvtpk(v1[2], v1[3]);
                        *(u32x4*)(VT + (size_t)ch * T + tok0 + bj * 128) = w;
                    }
                }
        }
    }
};

struct EpiG2 {
    static constexpr bool PERM = true;
    const float* x0; const unsigned short* rsrc; unsigned short* rdst;
    const float* xc0; unsigned short* rc;
    const float* gate; const float* rstat; const float* png; const float* pnb;
    DI void operator()(const f32x4 (&acc)[2][2][4][2], const Unit& u, int wr, int wc, int fr, int fq) const {
        const bool norm = x0 == nullptr;
        const int cb = u.pn * 256 + wc * 32 + 8 * fq;
        const float* gp = gate + (u.pm >> 4) * 3072 + cb;
        const int rbase = u.pm * 256 + wr * 64 + fr;
        const float* sp = rstat + (size_t)rbase * 2;
#pragma unroll
        for (int bj = 0; bj < 2; ++bj) {
            const int co = bj * 128;
            const f32x4 g0 = *(const f32x4*)(gp + co), g1 = *(const f32x4*)(gp + co + 4);
            f32x4 ng0 = {1.f, 1.f, 1.f, 1.f}, ng1 = ng0, nb0 = {0.f, 0.f, 0.f, 0.f}, nb1 = nb0;
            if (norm) { ng0 = *(const f32x4*)(png + cb + co); ng1 = *(const f32x4*)(png + cb + co + 4); nb0 = *(const f32x4*)(pnb + cb + co); nb1 = *(const f32x4*)(pnb + cb + co + 4); }
#pragma unroll
            for (int ai = 0; ai < 2; ++ai) {
                f32x4 xa[4], xb[4];
                if (norm) { u32x4 rv[4]; f32x2 st[4];
#pragma unroll
                    for (int m = 0; m < 4; ++m) { const int ro = ai * 128 + m * 16; rv[m] = *(const u32x4*)(rsrc + (size_t)(rbase + ro) * DM + cb + co); st[m] = *(const f32x2*)(sp + ro * 2); }
#pragma unroll
                    for (int m = 0; m < 4; ++m) { xa[m] = (f32x4){hlo(rv[m].x), hhi(rv[m].x), hlo(rv[m].y), hhi(rv[m].y)}; xb[m] = (f32x4){hlo(rv[m].z), hhi(rv[m].z), hlo(rv[m].w), hhi(rv[m].w)};
                        xa[m] = (xa[m] - st[m].x) * st[m].y * ng0 + nb0; xb[m] = (xb[m] - st[m].x) * st[m].y * ng1 + nb1; } }
                else {
#pragma unroll
                    for (int m = 0; m < 4; ++m) { const size_t off = (size_t)(rbase + ai * 128 + m * 16) * DM + cb + co;
                        xa[m] = __builtin_nontemporal_load((const f32x4*)(x0 + off)); xb[m] = __builtin_nontemporal_load((const f32x4*)(x0 + off + 4)); } }
#pragma unroll
                for (int m = 0; m < 4; ++m) { const size_t off = (size_t)(rbase + ai * 128 + m * 16) * DM + cb + co;
                    const f32x4 ra = xa[m] * ALPHA + g0 * acc[ai][bj][m][0], rb = xb[m] * ALPHA + g1 * acc[ai][bj][m][1];
                    u32x4 w; w.x = pkh(ra[0], ra[1]); w.y = pkh(ra[2], ra[3]); w.z = pkh(rb[0], rb[1]); w.w = pkh(rb[2], rb[3]);
                    *(u32x4*)(rdst + off) = w; }
            }
        }
    }
};

struct Params {
    const float* x; const float* c; const float* ctx; const float* c_ctx; const float* ada_w; const float* ada_b; const float* ln_g; const float* ln_b;
    const float* a_w_in; const float* a_ln_g; const float* a_ln_b; const float* a_w_s; const float* a_b_s; const float* a_w_out;
    const float* b_w_in; const float* b_sink; const float* b_w_out;
    float* out; unsigned char* ws;
};


DI void g2_ctx_small(const Params& P, LAS unsigned char* lds, const bf16_t* A  , const bf16_t* Bt, const int K, const EpiG2& E) {
    const int tid = opaque_tid(), lane = tid & 63, wave = __builtin_amdgcn_readfirstlane(tid >> 6);
    const int r16 = lane & 15, kq = lane >> 4;
    const int kw = K >> 3;
    LAS float* part = (LAS float*)lds;
    for (int tile = blockIdx.x; tile < 256; tile += gridDim.x) {
        const int tm = tile >> 4, tn = tile & 15;
        const bf16_t* ap = A + (size_t)(64 * tm + r16) * K + wave * kw + 8 * kq;
        const bf16_t* bp = Bt + (size_t)(64 * tn + r16) * K + wave * kw + 8 * kq;
        f32x4 acc[4][4];
#pragma unroll
        for (int i = 0; i < 4; ++i)
#pragma unroll
            for (int jj = 0; jj < 4; ++jj) acc[i][jj] = (f32x4){0.f, 0.f, 0.f, 0.f};
        bf16x8 a[2][4], b[2][4];
#pragma unroll
        for (int i = 0; i < 4; ++i) { a[0][i] = *(const bf16x8*)(ap + (size_t)(16 * i) * K); b[0][i] = *(const bf16x8*)(bp + (size_t)(16 * i) * K); }
#pragma unroll 1
        for (int k0 = 0; k0 < kw; k0 += 64) {
#pragma unroll
            for (int i = 0; i < 4; ++i) { a[1][i] = *(const bf16x8*)(ap + (size_t)(16 * i) * K + k0 + 32); b[1][i] = *(const bf16x8*)(bp + (size_t)(16 * i) * K + k0 + 32); }
#pragma unroll
            for (int i = 0; i < 4; ++i)
#pragma unroll
                for (int jj = 0; jj < 4; ++jj) acc[i][jj] = __builtin_amdgcn_mfma_f32_16x16x32_bf16(a[0][i], b[0][jj], acc[i][jj], 0, 0, 0);
            const int kn = (k0 + 64 < kw) ? (k0 + 64) : (kw - 32);
#pragma unroll
            for (int i = 0; i < 4; ++i) { a[0][i] = *(const bf16x8*)(ap + (size_t)(16 * i) * K + kn); b[0][i] = *(const bf16x8*)(bp + (size_t)(16 * i) * K + kn); }
#pragma unroll
            for (int i = 0; i < 4; ++i)
#pragma unroll
                for (int jj = 0; jj < 4; ++jj) acc[i][jj] = __builtin_amdgcn_mfma_f32_16x16x32_bf16(a[1][i], b[1][jj], acc[i][jj], 0, 0, 0);
        }
        __syncthreads();
#pragma unroll
        for (int i = 0; i < 4; ++i)
#pragma unroll
            for (int jj = 0; jj < 4; ++jj)
#pragma unroll
                for (int q = 0; q < 4; ++q) part[wave * 4096 + (16 * i + 4 * kq + q) * 64 + 16 * jj + r16] = acc[i][jj][q];
        __syncthreads();
        { const int row = tid >> 3, c0 = (tid & 7) * 8;
          f32x4 s0 = {0.f, 0.f, 0.f, 0.f}, s1 = s0;
#pragma unroll
          for (int w = 0; w < 8; ++w) { s0 += *(const LAS f32x4*)(part + w * 4096 + row * 64 + c0); s1 += *(const LAS f32x4*)(part + w * 4096 + row * 64 + c0 + 4); }
          const int crow = 64 * tm + row, col = 64 * tn + c0;
          const float* gp = E.gate + 4 * 3072 + col;
          const size_t off = (size_t)crow * DM + col;
          f32x4 x0, x1;
          if (E.xc0 != nullptr) { x0 = *(const f32x4*)(E.xc0 + off); x1 = *(const f32x4*)(E.xc0 + off + 4); }
          else { const u32x4 rv = *(const u32x4*)(E.rc + off); const f32x2 st = *(const f32x2*)(E.rstat + (size_t)(TL + crow) * 2);
              x0 = (f32x4){hlo(rv.x), hhi(rv.x), hlo(rv.y), hhi(rv.y)}; x1 = (f32x4){hlo(rv.z), hhi(rv.z), hlo(rv.w), hhi(rv.w)};
              x0 = (x0 - st.x) * st.y * *(const f32x4*)(E.png + col) + *(const f32x4*)(E.pnb + col);
              x1 = (x1 - st.x) * st.y * *(const f32x4*)(E.png + col + 4) + *(const f32x4*)(E.pnb + col + 4); }
          const f32x4 ra = x0 * ALPHA + *(const f32x4*)gp * s0, rb = x1 * ALPHA + *(const f32x4*)(gp + 4) * s1;
          u32x4 w; w.x = pkh(ra[0], ra[1]); w.y = pkh(ra[2], ra[3]); w.z = pkh(rb[0], rb[1]); w.w = pkh(rb[2], rb[3]);
          *(u32x4*)(E.rc + off) = w; }
    }
    __syncthreads();
}

DI void transpose_item(const float* W, int N, int K, bf16_t* WTrow  , int k0, int n0, LAS float* scr, int lane) {
    f32x4 tv[8];
#pragma unroll
    for (int i = 0; i < 8; ++i) tv[i] = __builtin_nontemporal_load((const f32x4*)(W + (size_t)(k0 + 8 * i + (lane >> 3)) * N + n0 + 4 * (lane & 7)));
#pragma unroll
    for (int i = 0; i < 8; ++i) { LAS float* d = scr + (8 * i + (lane >> 3)) * 33 + 4 * (lane & 7); d[0] = tv[i][0]; d[1] = tv[i][1]; d[2] = tv[i][2]; d[3] = tv[i][3]; }
    asm volatile("s_waitcnt lgkmcnt(0)" ::: "memory");
    const int c = lane & 7;
#pragma unroll
    for (int j = 0; j < 4; ++j) { const int n = (lane >> 3) + 8 * j; const LAS float* s = scr + (8 * c) * 33 + n;
        u32x4 o; o.x = cvtpk(s[0 * 33], s[1 * 33]); o.y = cvtpk(s[2 * 33], s[3 * 33]); o.z = cvtpk(s[4 * 33], s[5 * 33]); o.w = cvtpk(s[6 * 33], s[7 * 33]);
        *(u32x4*)(WTrow + (size_t)n * K + k0 + 8 * c) = o; }
    asm volatile("s_waitcnt lgkmcnt(0)" ::: "memory");
}

DI void p0_prologue(const Params& P, LAS unsigned char* lds) {
    const int tid = opaque_tid(), lane = tid & 63, wave = __builtin_amdgcn_readfirstlane(tid >> 6);
    unsigned char* ws = P.ws;
    {
        LAS float* scond = (LAS float*)lds;
        LAS float* red = (LAS float*)(lds + 32768);
        for (int idx = tid; idx < 5 * 1024; idx += NTHREADS) { const int r = idx >> 10, k = idx & 1023; const float v = r < 4 ? P.c[r * 1024 + k] : P.c_ctx[k]; scond[idx] = silu_f(v); }
        __syncthreads();
        for (int item = blockIdx.x; item < 192; item += gridDim.x) {
            const int li = item / 48, cc = item % 48, n = cc * 64 + lane;
            const float* wp = P.ada_w + (size_t)li * 1024 * 3072 + (size_t)(wave * 128) * 3072 + n;
            float a0 = 0.f, a1 = 0.f, a2 = 0.f, a3 = 0.f, a4 = 0.f;
#pragma unroll 1
            for (int kb = 0; kb < 128; kb += 32) {
                float wv[32];
#pragma unroll
                for (int k = 0; k < 32; ++k) wv[k] = __builtin_nontemporal_load(wp + (size_t)(kb + k) * 3072);
#pragma unroll
                for (int k = 0; k < 32; ++k) { const float w = wv[k]; const int kk = wave * 128 + kb + k;
                    a0 += scond[kk] * w; a1 += scond[1024 + kk] * w; a2 += scond[2048 + kk] * w; a3 += scond[3072 + kk] * w; a4 += scond[4096 + kk] * w; } }
            red[(wave * 5 + 0) * 64 + lane] = a0; red[(wave * 5 + 1) * 64 + lane] = a1; red[(wave * 5 + 2) * 64 + lane] = a2; red[(wave * 5 + 3) * 64 + lane] = a3; red[(wave * 5 + 4) * 64 + lane] = a4;
            __syncthreads();
            if (tid < 320) { const int r = tid >> 6, l = tid & 63; float s = P.ada_b[li * 3072 + cc * 64 + l];
#pragma unroll
                for (int w = 0; w < 8; ++w) s += red[(w * 5 + r) * 64 + l];
                ((float*)(ws + WS_MOD))[(li * 5 + r) * 3072 + cc * 64 + l] = s; }
            __syncthreads();
        }
    }
    if (blockIdx.x == gridDim.x - 1) {
        float* rope = (float*)(ws + WS_ROPE);
        for (int idx = tid; idx < 1024; idx += NTHREADS) { const int pos = idx >> 4, f = idx & 15;
            const float inv = exp2f(-(float)f * (13.287712379549449f / 16.0f)); const float ang = (float)pos * inv;
            rope[idx] = __cosf(ang); rope[1024 + idx] = __sinf(ang); }
    }
    __syncthreads();
    {
        LAS float* scr = (LAS float*)(lds + wave * 16384);
        const int gw = blockIdx.x * NWAVES + wave, NGW = gridDim.x * NWAVES;
        constexpr int I_AIN = 16 * 192, I_AOUT = 32 * 32, I_BIN = 16 * 80, I_BOUT = 16 * 32, I_PER = I_AIN + I_AOUT + I_BIN + I_BOUT;
        for (int it = gw; it < 2 * I_PER; it += NGW) {
            const int j = it / I_PER; int r = it % I_PER;
            unsigned char* wa = ws + WS_WA0 + (size_t)j * WA_SIZE; unsigned char* wb = ws + WS_WB0 + (size_t)j * WB_SIZE;
            if (r < I_AIN) { const int kb = r / 192, nb = r % 192, n0 = nb * 32; bf16_t* dst;
                if (n0 < 2048) dst = (bf16_t*)(wa + WA_UZ) + (size_t)(256 * (n0 >> 7) + (n0 & 127)) * 1024;
                else if (n0 < 4096) dst = (bf16_t*)(wa + WA_V) + (size_t)(n0 - 2048) * 1024;
                else { const int n1 = n0 - 4096; dst = (bf16_t*)(wa + WA_UZ) + (size_t)(256 * (n1 >> 7) + 128 + (n1 & 127)) * 1024; }
                transpose_item(P.a_w_in + (size_t)j * 1024 * 6144, 6144, 1024, dst, kb * 64, n0, scr, lane); continue; }
            r -= I_AIN;
            if (r < I_AOUT) { const int kb = r / 32, nb = r % 32, n0 = nb * 32;
                transpose_item(P.a_w_out + (size_t)j * 2048 * 1024, 1024, 2048, (bf16_t*)(wa + WA_OUT) + (size_t)n0 * 2048, kb * 64, n0, scr, lane); continue; }
            r -= I_AOUT;
            if (r < I_BIN) { const int kb = r / 80, nb = r % 80, n0 = nb * 32; bf16_t* dst;
                if (n0 < 1280) dst = (bf16_t*)(wb + WB_QKZ) + (size_t)n0 * 1024;
                else if (n0 < 1536) dst = (bf16_t*)(wb + WB_V) + (size_t)(n0 - 1280) * 1024;
                else dst = (bf16_t*)(wb + WB_QKZ) + (size_t)(n0 - 256) * 1024;
                transpose_item(P.b_w_in + (size_t)j * 1024 * 2560, 2560, 1024, dst, kb * 64, n0, scr, lane); continue; }
            r -= I_BIN;
            { const int kb = r / 32, nb = r % 32, n0 = nb * 32;
                transpose_item(P.b_w_out + (size_t)j * 1024 * 1024, 1024, 1024, (bf16_t*)(wb + WB_OUT) + (size_t)n0 * 1024, kb * 64, n0, scr, lane); }
        }
        const int gt = blockIdx.x * NTHREADS + tid, NGT = gridDim.x * NTHREADS;
        for (int i = gt; i < 2 * 8 * 128 * 128 / 8; i += NGT) { const int j = i >> 14, e = (i & 16383) * 8;
            const f32x4 v0 = *(const f32x4*)(P.a_w_s + (size_t)j * 131072 + e), v1 = *(const f32x4*)(P.a_w_s + (size_t)j * 131072 + e + 4);
            u32x4 w; w.x = cvtpk(v0[0], v0[1]); w.y = cvtpk(v0[2], v0[3]); w.z = cvtpk(v1[0], v1[1]); w.w = cvtpk(v1[2], v1[3]);
            *(u32x4*)((bf16_t*)(ws + WS_WA0 + (size_t)j * WA_SIZE + WA_S) + e) = w; }
    }
}

DI void p0b_h0(const Params& P) {
    const int tid = opaque_tid(), lane = tid & 63, wave = __builtin_amdgcn_readfirstlane(tid >> 6);
    const int gw = blockIdx.x * NWAVES + wave, NGW = gridDim.x * NWAVES;
    const float* mod = (const float*)(P.ws + WS_MOD);
    bf16_t* H = (bf16_t*)(P.ws + WS_H);
    for (int row = 2 * gw; row < T; row += 2 * NGW) {
        const float* xr = row < TL ? P.x + (size_t)row * DM : P.ctx + (size_t)(row - TL) * DM;
        const float* mr = mod + (row < TL ? (row >> 12) : 4) * 3072;
        f32x4 v[2][4], sh[4], sc[4];
#pragma unroll
        for (int q = 0; q < 2; ++q)
#pragma unroll
            for (int j = 0; j < 4; ++j) v[q][j] = __builtin_nontemporal_load((const f32x4*)(xr + q * DM + 4 * lane + 256 * j));
#pragma unroll
        for (int j = 0; j < 4; ++j) { const int c = 4 * lane + 256 * j; sh[j] = *(const f32x4*)(mr + c); sc[j] = *(const f32x4*)(mr + 1024 + c) + 1.0f; }
#pragma unroll
        for (int q = 0; q < 2; ++q)
#pragma unroll
            for (int j = 0; j < 4; ++j) { const int c = 4 * lane + 256 * j;
                const f32x4 h = v[q][j] * sc[j] + sh[j];
                u32x2 w; w.x = cvtpk(h[0], h[1]); w.y = cvtpk(h[2], h[3]);
                *(u32x2*)(H + (size_t)(row + q) * DM + c) = w; }
    }
}

DI void ln_phase(const Params& P, int layer) {
    const int tid = opaque_tid(), lane = tid & 63, wave = __builtin_amdgcn_readfirstlane(tid >> 6);
    const int gw = blockIdx.x * NWAVES + wave, NGW = gridDim.x * NWAVES;
    const bool last = layer == 3;
    const float* modn = (const float*)(P.ws + WS_MOD) + (layer + 1) * 15360;
    const float* lg = P.ln_g + layer * DM; const float* lb = P.ln_b + layer * DM;
    bf16_t* H = (bf16_t*)(P.ws + WS_H);
    const unsigned short* rl = last ? (const unsigned short*)(P.ws + WS_H) : (const unsigned short*)P.out;
    const unsigned short* rc = (const unsigned short*)(P.ws + WS_XC);
    float* rstat = (float*)(P.ws + WS_RSTAT);
    const int nrows = last ? TL : T;
    f32x4 g_[4], b_[4];
#pragma unroll
    for (int j = 0; j < 2; ++j) { const int c = 8 * lane + 512 * j; g_[2 * j] = *(const f32x4*)(lg + c); g_[2 * j + 1] = *(const f32x4*)(lg + c + 4); b_[2 * j] = *(const f32x4*)(lb + c); b_[2 * j + 1] = *(const f32x4*)(lb + c + 4); }
    for (int row = 2 * gw; row < nrows; row += 2 * NGW) {
        const unsigned short* xr = row < TL ? rl + (size_t)row * DM : rc + (size_t)(row - TL) * DM;
        const float* mr = modn + (row < TL ? (row >> 12) : 4) * 3072;
        u32x4 rv[2][2];
#pragma unroll
        for (int q = 0; q < 2; ++q)
#pragma unroll
            for (int j = 0; j < 2; ++j) rv[q][j] = *(const u32x4*)(xr + q * DM + 8 * lane + 512 * j);
        f32x4 G2_[4], B2_[4];
        if (!last) {
#pragma unroll
            for (int j = 0; j < 2; ++j) { const int c = 8 * lane + 512 * j;
                const f32x4 sca = *(const f32x4*)(mr + 1024 + c) + 1.0f, scb = *(const f32x4*)(mr + 1024 + c + 4) + 1.0f, sha = *(const f32x4*)(mr + c), shb = *(const f32x4*)(mr + c + 4);
                G2_[2 * j] = g_[2 * j] * sca; G2_[2 * j + 1] = g_[2 * j + 1] * scb; B2_[2 * j] = b_[2 * j] * sca + sha; B2_[2 * j + 1] = b_[2 * j + 1] * scb + shb; }
        } else {
#pragma unroll
            for (int i = 0; i < 4; ++i) { G2_[i] = g_[i]; B2_[i] = b_[i]; }
        }
        f32x4 v[2][4]; float s[2] = {0.f, 0.f};
#pragma unroll
        for (int q = 0; q < 2; ++q)
#pragma unroll
            for (int j = 0; j < 2; ++j) { const u32x4 t = rv[q][j];
                v[q][2 * j] = (f32x4){hlo(t.x), hhi(t.x), hlo(t.y), hhi(t.y)}; v[q][2 * j + 1] = (f32x4){hlo(t.z), hhi(t.z), hlo(t.w), hhi(t.w)}; }
#pragma unroll
        for (int q = 0; q < 2; ++q)
#pragma unroll
            for (int j = 0; j < 4; ++j) s[q] += (v[q][j][0] + v[q][j][1]) + (v[q][j][2] + v[q][j][3]);
#pragma unroll
        for (int q = 0; q < 2; ++q) s[q] = wave_sum_dpp(s[q]);
        float mean[2], s2[2] = {0.f, 0.f};
#pragma unroll
        for (int q = 0; q < 2; ++q) { mean[q] = s[q] * (1.f / DM);
#pragma unroll
            for (int j = 0; j < 4; ++j) { v[q][j] = v[q][j] - mean[q]; s2[q] += (v[q][j][0] * v[q][j][0] + v[q][j][1] * v[q][j][1]) + (v[q][j][2] * v[q][j][2] + v[q][j][3] * v[q][j][3]); } }
#pragma unroll
        for (int q = 0; q < 2; ++q) s2[q] = wave_sum_dpp(s2[q]);
#pragma unroll
        for (int q = 0; q < 2; ++q) {
            const float rstd = 1.0f / sqrtf(s2[q] * (1.f / DM) + LN_EPS);
#pragma unroll
            for (int j = 0; j < 2; ++j) { const int c = 8 * lane + 512 * j;
                const f32x4 ya = v[q][2 * j] * rstd * G2_[2 * j] + B2_[2 * j], yb = v[q][2 * j + 1] * rstd * G2_[2 * j + 1] + B2_[2 * j + 1];
                if (last) { float* op = P.out + (size_t)(row + q) * DM + c; __builtin_nontemporal_store(ya, (f32x4*)op); __builtin_nontemporal_store(yb, (f32x4*)(op + 4)); }
                else { u32x4 w; w.x = cvtpk(ya[0], ya[1]); w.y = cvtpk(ya[2], ya[3]); w.z = cvtpk(yb[0], yb[1]); w.w = cvtpk(yb[2], yb[3]);
                    *(u32x4*)(H + (size_t)(row + q) * DM + c) = w; }
            }
            if (!last && lane == 0) *(f32x2*)(rstat + (size_t)(row + q) * 2) = (f32x2){mean[q], rstd};
        }
    }
}

DI void spatial_mix(const Params& P, int j, LAS unsigned char* lds) {
    const int tid = opaque_tid(), lane = tid & 63, wave = __builtin_amdgcn_readfirstlane(tid >> 6);
    const bf16_t* Wsb = (const bf16_t*)(P.ws + WS_WA0 + (size_t)j * WA_SIZE + WA_S);
    const float* bs = P.a_b_s + j * 1024; const float* lng = P.a_ln_g + j * AW; const float* lnb = P.a_ln_b + j * AW;
    const bf16_t* VT = (const bf16_t*)(P.ws + WS_ACT + ACT_VTA); bf16_t* UZ = (bf16_t*)(P.ws + WS_ACT + ACT_UZ);
    const float* stat = (const float*)(P.ws + WS_STAT);
    LAS unsigned char* Wl = lds;
    LAS float* smu = (LAS float*)(lds + 36864);
    const int r16 = lane & 15, kq = lane >> 4;
    const bool hoist = (gridDim.x & 7) == 0 && gridDim.x * 8 >= 136 * 8;
    if (hoist) {
        const int g = blockIdx.x & 7;
#pragma unroll
        for (int i = 0; i < 4; ++i) { const int piece = tid + NTHREADS * i, row = piece >> 4, cp = piece & 15;
            *(LAS u32x4*)(Wl + row * 272 + cp * 16) = *(const u32x4*)(Wsb + (size_t)g * 16384 + row * 128 + cp * 8); }
        for (int t = tid; t < 8 * 128; t += NTHREADS) { const int it = t >> 7, item = blockIdx.x + it * gridDim.x;
            if (item < 136 * 8) { const float* sp = stat + (size_t)((item >> 3) * 128 + (t & 127)) * 32; float a = 0.f, b = 0.f;
#pragma unroll
                for (int q8 = 0; q8 < 8; ++q8) { const f32x4 q = *(const f32x4*)(sp + 4 * q8); a += q[0] + q[2]; b += q[1] + q[3]; }
                const float mu = a * (1.f / AW); const float var = fmaxf(b * (1.f / AW) - mu * mu, 0.f);
                smu[it * 256 + (t & 127)] = mu; smu[it * 256 + 128 + (t & 127)] = 1.0f / sqrtf(var + LN_EPS); } }
        __syncthreads();
    }
    int itn = 0;
    for (int item = blockIdx.x; item < 136 * 8; item += gridDim.x, ++itn) {
        const int chunk = item >> 3, g = item & 7;
        if (!hoist) {
        __syncthreads();
        if (tid < 128) { const float* sp = stat + (size_t)(chunk * 128 + tid) * 32; float a = 0.f, b = 0.f;
#pragma unroll
            for (int s = 0; s < 8; ++s) { const f32x4 q = *(const f32x4*)(sp + 4 * s); a += q[0] + q[2]; b += q[1] + q[3]; }
            const float mu = a * (1.f / AW); const float var = fmaxf(b * (1.f / AW) - mu * mu, 0.f);
            smu[tid] = mu; smu[128 + tid] = 1.0f / sqrtf(var + LN_EPS); }
#pragma unroll
        for (int i = 0; i < 4; ++i) { const int piece = tid + NTHREADS * i, row = piece >> 4, cp = piece & 15;
            *(LAS u32x4*)(Wl + row * 272 + cp * 16) = *(const u32x4*)(Wsb + (size_t)g * 16384 + row * 128 + cp * 8); }
        __syncthreads();
        }
        const LAS float* smu_i = smu + (hoist ? itn * 256 : 0); const LAS float* srs_i = smu_i + 128;
        const int cw = g * 256 + 32 * wave;
        u32x4 gvr[2][4]; float ga[2], be[2];
#pragma unroll
        for (int ct = 0; ct < 2; ++ct) { const int ch = cw + 8 * (r16 >> 2) + 4 * ct + (r16 & 3);
            ga[ct] = lng[ch]; be[ct] = lnb[ch];
#pragma unroll
            for (int ks = 0; ks < 4; ++ks) gvr[ct][ks] = *(const u32x4*)(VT + (size_t)ch * T + chunk * 128 + 32 * ks + 8 * kq); }
        u32x4 uzr[8];
        float bsr[8];
#pragma unroll
        for (int pt = 0; pt < 8; ++pt) bsr[pt] = bs[g * 128 + 16 * pt + r16];
        __builtin_amdgcn_sched_barrier(0);
#pragma unroll
        for (int pt = 0; pt < 8; ++pt) uzr[pt] = *(const u32x4*)(UZ + (size_t)(chunk * 128 + 16 * pt + r16) * AW + cw + 8 * kq);
        f32x4 acc[2][8];
#pragma unroll
        for (int ct = 0; ct < 2; ++ct)
#pragma unroll
            for (int pt = 0; pt < 8; ++pt) acc[ct][pt] = (f32x4){0.f, 0.f, 0.f, 0.f};
#pragma unroll
        for (int ks = 0; ks < 4; ++ks) {
            const f32x4 m0 = *(const LAS f32x4*)(smu_i + 32 * ks + 8 * kq), m1 = *(const LAS f32x4*)(smu_i + 32 * ks + 8 * kq + 4);
            const f32x4 r0 = *(const LAS f32x4*)(srs_i + 32 * ks + 8 * kq), r1 = *(const LAS f32x4*)(srs_i + 32 * ks + 8 * kq + 4);
            bf16x8 af[2];
#pragma unroll
            for (int ct = 0; ct < 2; ++ct) { const u32x4 gq = gvr[ct][ks];
                u32x4 w;
                w.x = cvtpk((bflo(gq.x) - m0[0]) * r0[0] * ga[ct] + be[ct], (bfhi(gq.x) - m0[1]) * r0[1] * ga[ct] + be[ct]);
                w.y = cvtpk((bflo(gq.y) - m0[2]) * r0[2] * ga[ct] + be[ct], (bfhi(gq.y) - m0[3]) * r0[3] * ga[ct] + be[ct]);
                w.z = cvtpk((bflo(gq.z) - m1[0]) * r1[0] * ga[ct] + be[ct], (bfhi(gq.z) - m1[1]) * r1[1] * ga[ct] + be[ct]);
                w.w = cvtpk((bflo(gq.w) - m1[2]) * r1[2] * ga[ct] + be[ct], (bfhi(gq.w) - m1[3]) * r1[3] * ga[ct] + be[ct]);
                af[ct] = __builtin_bit_cast(bf16x8, w); }
#pragma unroll
            for (int pt = 0; pt < 8; ++pt) { const bf16x8 bfr = *(const LAS bf16x8*)(Wl + (16 * pt + r16) * 272 + (32 * ks + 8 * kq) * 2);
                acc[0][pt] = __builtin_amdgcn_mfma_f32_16x16x32_bf16(af[0], bfr, acc[0][pt], 0, 0, 0);
                acc[1][pt] = __builtin_amdgcn_mfma_f32_16x16x32_bf16(af[1], bfr, acc[1][pt], 0, 0, 0); }
        }
#pragma unroll
        for (int pt = 0; pt < 8; ++pt) { const int p = 16 * pt + r16; const float bsv = bsr[pt];
            bf16_t* up = UZ + (size_t)(chunk * 128 + p) * AW + cw + 8 * kq;
            const u32x4 uz = uzr[pt]; const f32x4 a0 = acc[0][pt], a1 = acc[1][pt];
            u32x4 w; w.x = cvtpk(bflo(uz.x) * (a0[0] + bsv), bfhi(uz.x) * (a0[1] + bsv)); w.y = cvtpk(bflo(uz.y) * (a0[2] + bsv), bfhi(uz.y) * (a0[3] + bsv));
            w.z = cvtpk(bflo(uz.z) * (a1[0] + bsv), bfhi(uz.z) * (a1[1] + bsv)); w.w = cvtpk(bflo(uz.w) * (a1[2] + bsv), bfhi(uz.w) * (a1[3] + bsv));
            *(u32x4*)up = w; }
    }
}

DI void attn_phase(const Params& P, int j, bool ctxq, LAS unsigned char* lds) {
    const int tid = opaque_tid(), lane = tid & 63, wave = __builtin_amdgcn_readfirstlane(tid >> 6);
    const bf16_t* Q = (const bf16_t*)(P.ws + WS_ACT + ACT_Q); const bf16_t* Kb = (const bf16_t*)(P.ws + WS_ACT + ACT_K);
    const bf16_t* VT = (const bf16_t*)(P.ws + WS_ACT + ACT_VTB); const bf16_t* Z = (const bf16_t*)(P.ws + WS_ACT + ACT_Z); bf16_t* OZ = (bf16_t*)(P.ws + WS_ACT + ACT_OZ);
    const float* sink = P.b_sink + j * 16;
    const int r = lane & 31, h = lane >> 5;
    const int nitems = 1024 + (ctxq ? 64 : 0);
    const int g = wave >> 1, sub = wave & 1;
    constexpr int KP = 144, VP = 136, VOFF = 64 * KP, BUFB = VOFF + 64 * VP;
    const int lrow = tid >> 3, lpc = tid & 7;
    const int vrow = 32 * ((lrow >> 2) & 1) + 8 * (lrow >> 4) + 4 * ((lrow >> 3) & 1) + (lrow & 3);
    const int kw_off = lrow * KP + lpc * 16, vw_off = VOFF + vrow * VP + lpc * 16;
    const int kfo = r * KP + 16 * h, vfo = VOFF + r * VP + 8 * h;
    const int vcu = (gridDim.x % 8 == 0) ? (int)((blockIdx.x % 8) * (gridDim.x / 8) + blockIdx.x / 8) : (int)blockIdx.x;
    for (int bi = vcu; bi < nitems; bi += gridDim.x) {
        int b, kvh, qrow0, jt_lo, nband, bandrow0, ctxrow0;
        if (bi < 1024) { b = bi >> 8; kvh = (bi >> 6) & 3; const int q64 = bi & 63, qbase = 64 * q64; qrow0 = b * SEQ + qbase + 32 * sub;
            jt_lo = (4 - 2 * q64) > 0 ? (4 - 2 * q64) : 0; const int jt_hi = (131 - 2 * q64) < 9 ? (131 - 2 * q64) : 9; nband = jt_hi - jt_lo + 1; bandrow0 = b * SEQ + qbase - 128; }
        else { const int ci = bi - 1024; b = ci >> 4; kvh = (ci >> 2) & 3; qrow0 = TL + b * CL + 64 * (ci & 3) + 32 * sub; jt_lo = 0; nband = 0; bandrow0 = 0; }
        ctxrow0 = TL + b * CL;
        const int NT = nband + 8, NS = (NT + 1) >> 1;
        const int head = kvh * 4 + g;
        const bf16_t* ksrc = Kb + (size_t)(lrow & 31) * 256 + kvh * 64 + lpc * 8;
        const bf16_t* vsrc = VT + (size_t)(kvh * 64 + lrow) * T + (lpc & 3) * 8;
#define ATT_KROW(i) ((i) < nband ? (bandrow0 + 32 * (jt_lo + (i))) : (ctxrow0 + 32 * ((i) - nband)))
#define ATT_TIDX(st, w) ((2 * (st) + (w)) < NT ? (2 * (st) + (w)) : (NT - 1))
#define ATT_GLOADK(st) (*(const u32x4*)(ksrc + (size_t)ATT_KROW(ATT_TIDX(st, lrow >> 5)) * 256))
#define ATT_GLOADV(st) (*(const u32x4*)(vsrc + (size_t)ATT_KROW(ATT_TIDX(st, lpc >> 2))))
#define ATT_LWRITE(bufi, kv, vv) do { LAS unsigned char* _p = lds + (bufi) * BUFB; *(LAS u32x4*)(_p + kw_off) = (kv); \
            *(LAS u32x2*)(_p + vw_off) = (u32x2){(vv).x, (vv).y}; *(LAS u32x2*)(_p + vw_off + 8) = (u32x2){(vv).z, (vv).w}; } while (0)
        bf16x8 qf[4];
#pragma unroll
        for (int s = 0; s < 4; ++s) qf[s] = *(const bf16x8*)(Q + (size_t)(qrow0 + r) * 1024 + head * 64 + 16 * s + 8 * h);
        const size_t obase = (size_t)(qrow0 + r) * 1024 + head * 64 + 8 * h;
        u32x4 zr[4];
#pragma unroll
        for (int g4 = 0; g4 < 4; ++g4) zr[g4] = *(const u32x4*)(Z + obase + 16 * g4);
        float m_run = sink[head] * LOG2E; float l_part = (h == 0) ? 1.f : 0.f;
        f32x16 o0, o1;
#pragma unroll
        for (int i = 0; i < 16; ++i) { o0[i] = 0.f; o1[i] = 0.f; }
        __syncthreads();
        u32x4 rk[2], rv[2];
        rk[0] = ATT_GLOADK(0); rv[0] = ATT_GLOADV(0); rk[1] = ATT_GLOADK(1); rv[1] = ATT_GLOADV(1);
        ATT_LWRITE(0, rk[0], rv[0]);
        __syncthreads();
        for (int st0 = 0; st0 < NS; st0 += 2) {
#pragma unroll
            for (int u2 = 0; u2 < 2; ++u2) {
                const int st = st0 + u2;
                if (st < NS) {
                    rk[u2] = ATT_GLOADK(st + 2); rv[u2] = ATT_GLOADV(st + 2);
                    const LAS unsigned char* bp = lds + (st & 1) * BUFB;
                    int mode[2];
#pragma unroll
                    for (int w = 0; w < 2; ++w) { const int i = 2 * st + w; const int t = jt_lo + i - sub;
                        mode[w] = (i >= NT) ? 3 : ((i >= nband) ? 0 : ((t < 0 || t > 8) ? 3 : (t == 0 ? 1 : (t == 8 ? 2 : 0)))); }
                    const int mA = __builtin_amdgcn_readfirstlane(mode[0]), mB = __builtin_amdgcn_readfirstlane(mode[1]);
                    if ((mA | mB) != 0) {
                        asm volatile("" ::: "memory");
                    f32x16 S[2];
#pragma unroll
                        for (int w = 0; w < 2; ++w)
#pragma unroll
                            for (int q = 0; q < 16; ++q) S[w][q] = 0.f;
#pragma unroll
                        for (int s = 0; s < 4; ++s) {
                            const bf16x8 ka = *(const LAS bf16x8*)(bp + kfo + 32 * s), kb = *(const LAS bf16x8*)(bp + kfo + 32 * KP + 32 * s);
                            S[0] = __builtin_amdgcn_mfma_f32_32x32x16_bf16(ka, qf[s], S[0], 0, 0, 0); S[1] = __builtin_amdgcn_mfma_f32_32x32x16_bf16(kb, qf[s], S[1], 0, 0, 0); }
                        {
                        const int rr = r - 4 * h;
#pragma unroll
                        for (int w = 0; w < 2; ++w) { const int mw = w ? mB : mA;
                            if (mw == 1) {
#pragma unroll
                                for (int q = 0; q < 16; ++q) { const int c = (q & 3) + 8 * (q >> 2); S[w][q] = (c >= rr) ? S[w][q] : -1e30f; } }
                            else if (mw == 2) {
#pragma unroll
                                for (int q = 0; q < 16; ++q) { const int c = (q & 3) + 8 * (q >> 2); S[w][q] = (c <= rr) ? S[w][q] : -1e30f; } }
                            else if (mw == 3) {
#pragma unroll
                                for (int q = 0; q < 16; ++q) S[w][q] = -1e30f; } }
                        }
                    float mx = max3f(S[0][0], S[1][0], m_run);
#pragma unroll
                        for (int q = 1; q < 16; ++q) mx = max3f(mx, S[0][q], S[1][q]);
                        mx = fmaxf(mx, xhalf_f(mx));
                        if (__builtin_amdgcn_ballot_w64(mx - m_run > 8.0f) != 0ull) { const float alpha = __builtin_amdgcn_exp2f(m_run - mx); l_part *= alpha; m_run = mx;
#pragma unroll
                            for (int q = 0; q < 16; ++q) { o0[q] *= alpha; o1[q] *= alpha; } }
                        f32x2 ps2 = {0.f, 0.f}; const f32x2 mn2 = {m_run, m_run};
#pragma unroll
                        for (int w = 0; w < 2; ++w)
#pragma unroll
                            for (int q = 0; q < 16; q += 2) { const f32x2 d = (f32x2){S[w][q], S[w][q + 1]} - mn2;
                                const f32x2 e = {__builtin_amdgcn_exp2f(d.x), __builtin_amdgcn_exp2f(d.y)}; S[w][q] = e.x; S[w][q + 1] = e.y; ps2 += e; }
                        const float psum = ps2.x + ps2.y;
                        l_part += psum;
#pragma unroll
                        for (int w = 0; w < 2; ++w)
#pragma unroll
                            for (int s = 0; s < 2; ++s) { u32x4 pw; pw.x = cvtpk(S[w][8 * s], S[w][8 * s + 1]); pw.y = cvtpk(S[w][8 * s + 2], S[w][8 * s + 3]); pw.z = cvtpk(S[w][8 * s + 4], S[w][8 * s + 5]); pw.w = cvtpk(S[w][8 * s + 6], S[w][8 * s + 7]);
                                const bf16x8 pf = __builtin_bit_cast(bf16x8, pw);
                                const int vo = vfo + 64 * w + 32 * s;
                                const u32x2 a0 = *(const LAS u32x2*)(bp + vo), a1 = *(const LAS u32x2*)(bp + vo + 16);
                                const u32x2 c0 = *(const LAS u32x2*)(bp + vo + 32 * VP), c1 = *(const LAS u32x2*)(bp + vo + 32 * VP + 16);
                                const bf16x8 va = __builtin_bit_cast(bf16x8, (u32x4){a0.x, a0.y, a1.x, a1.y}), vb = __builtin_bit_cast(bf16x8, (u32x4){c0.x, c0.y, c1.x, c1.y});
                                o0 = __builtin_amdgcn_mfma_f32_32x32x16_bf16(va, pf, o0, 0, 0, 0); o1 = __builtin_amdgcn_mfma_f32_32x32x16_bf16(vb, pf, o1, 0, 0, 0); }
                    } else {
                    f32x16 S[2];
#pragma unroll
                        for (int w = 0; w < 2; ++w)
#pragma unroll
                            for (int q = 0; q < 16; ++q) S[w][q] = 0.f;
#pragma unroll
                        for (int s = 0; s < 4; ++s) {
                            const bf16x8 ka = *(const LAS bf16x8*)(bp + kfo + 32 * s), kb = *(const LAS bf16x8*)(bp + kfo + 32 * KP + 32 * s);
                            S[0] = __builtin_amdgcn_mfma_f32_32x32x16_bf16(ka, qf[s], S[0], 0, 0, 0); S[1] = __builtin_amdgcn_mfma_f32_32x32x16_bf16(kb, qf[s], S[1], 0, 0, 0); }
                    float mx = max3f(S[0][0], S[1][0], m_run);
#pragma unroll
                        for (int q = 1; q < 16; ++q) mx = max3f(mx, S[0][q], S[1][q]);
                        mx = fmaxf(mx, xhalf_f(mx));
                        if (__builtin_amdgcn_ballot_w64(mx - m_run > 8.0f) != 0ull) { const float alpha = __builtin_amdgcn_exp2f(m_run - mx); l_part *= alpha; m_run = mx;
#pragma unroll
                            for (int q = 0; q < 16; ++q) { o0[q] *= alpha; o1[q] *= alpha; } }
                        f32x2 ps2 = {0.f, 0.f}; const f32x2 mn2 = {m_run, m_run};
#pragma unroll
                        for (int w = 0; w < 2; ++w)
#pragma unroll
                            for (int q = 0; q < 16; q += 2) { const f32x2 d = (f32x2){S[w][q], S[w][q + 1]} - mn2;
                                const f32x2 e = {__builtin_amdgcn_exp2f(d.x), __builtin_amdgcn_exp2f(d.y)}; S[w][q] = e.x; S[w][q + 1] = e.y; ps2 += e; }
                        const float psum = ps2.x + ps2.y;
                        l_part += psum;
#pragma unroll
                        for (int w = 0; w < 2; ++w)
#pragma unroll
                            for (int s = 0; s < 2; ++s) { u32x4 pw; pw.x = cvtpk(S[w][8 * s], S[w][8 * s + 1]); pw.y = cvtpk(S[w][8 * s + 2], S[w][8 * s + 3]); pw.z = cvtpk(S[w][8 * s + 4], S[w][8 * s + 5]); pw.w = cvtpk(S[w][8 * s + 6], S[w][8 * s + 7]);
                                const bf16x8 pf = __builtin_bit_cast(bf16x8, pw);
                                const int vo = vfo + 64 * w + 32 * s;
                                const u32x2 a0 = *(const LAS u32x2*)(bp + vo), a1 = *(const LAS u32x2*)(bp + vo + 16);
                                const u32x2 c0 = *(const LAS u32x2*)(bp + vo + 32 * VP), c1 = *(const LAS u32x2*)(bp + vo + 32 * VP + 16);
                                const bf16x8 va = __builtin_bit_cast(bf16x8, (u32x4){a0.x, a0.y, a1.x, a1.y}), vb = __builtin_bit_cast(bf16x8, (u32x4){c0.x, c0.y, c1.x, c1.y});
                                o0 = __builtin_amdgcn_mfma_f32_32x32x16_bf16(va, pf, o0, 0, 0, 0); o1 = __builtin_amdgcn_mfma_f32_32x32x16_bf16(vb, pf, o1, 0, 0, 0); }
                    }
                    ATT_LWRITE((st + 1) & 1, rk[u2 ^ 1], rv[u2 ^ 1]);
                    __syncthreads();
                }
            }
        }
#undef ATT_KROW
#undef ATT_TIDX
#undef ATT_GLOADK
#undef ATT_GLOADV
#undef ATT_LWRITE
        const float l = l_part + __shfl_xor(l_part, 32); const float inv = 1.0f / l;
#pragma unroll
        for (int g4 = 0; g4 < 4; ++g4) { const u32x4 z = zr[g4]; u32x4 w;
            w.x = cvtpk(o0[4 * g4] * inv * bflo(z.x), o0[4 * g4 + 1] * inv * bfhi(z.x)); w.y = cvtpk(o0[4 * g4 + 2] * inv * bflo(z.y), o0[4 * g4 + 3] * inv * bfhi(z.y));
            w.z = cvtpk(o1[4 * g4] * inv * bflo(z.z), o1[4 * g4 + 1] * inv * bfhi(z.z)); w.w = cvtpk(o1[4 * g4 + 2] * inv * bflo(z.w), o1[4 * g4 + 3] * inv * bfhi(z.w));
            *(u32x4*)(OZ + obase + 16 * g4) = w; }
    }
}

#define XB_TMO      128
#define XB_XCNT(j)  (256  + 64 * (j))
#define XB_XSUB(j)  (1280 + 64 * (j))
#define XB_XGEN(j)  (2304 + 64 * (j))
#define XB_TOP      3328
#define XB_TOPGEN   3392
#define XCD_BAR_WORDS 3456
#define XB_SPIN_CAP (1u << 18)
DI unsigned xb_ld(unsigned* p)              { return __hip_atomic_load(p, __ATOMIC_RELAXED, __HIP_MEMORY_SCOPE_AGENT); }
DI unsigned xb_add(unsigned* p, unsigned v) { return __hip_atomic_fetch_add(p, v, __ATOMIC_RELAXED, __HIP_MEMORY_SCOPE_AGENT); }
DI unsigned xb_xcc_id() { return (unsigned)__builtin_amdgcn_s_getreg((3 << 11) | 20) & 0xFu; }
#define XB_SPIN(cond, bar) do { unsigned _sp = 0; while (cond) { __builtin_amdgcn_s_sleep(1); \
    if ((++_sp & 255u) == 0u) { if (xb_ld(&(bar)[XB_TMO])) break; if (_sp > XB_SPIN_CAP) { atomicAdd(&(bar)[XB_TMO], 1u); break; } } } } while (0)
struct XcdBarrier { unsigned* bar; unsigned x; volatile LAS unsigned* st; };
DI XcdBarrier xcd_barrier_post(unsigned* bar, volatile LAS unsigned* st) {
    XcdBarrier b; b.bar = bar; b.x = xb_xcc_id(); b.st = st;
    if (threadIdx.x == 0) (void)xb_add(&bar[XB_XCNT(b.x)], 1u);
    return b;
}
DI void xcd_barrier_census_wave(unsigned* bar, unsigned x, volatile LAS unsigned* st) {
    const unsigned G = gridDim.x * gridDim.y * gridDim.z;
    const unsigned lane = threadIdx.x & 63u;
    unsigned c, sum, sp = 0u;
    for (;;) {
        c = lane < 16u ? xb_ld(&bar[XB_XCNT(lane)]) : 0u;
        sum = c;
#pragma unroll
        for (int o = 1; o < 64; o <<= 1) sum += (unsigned)__shfl_xor((int)sum, o);
        if (sum == G) break;
        __builtin_amdgcn_s_sleep(1);
        if ((++sp & 255u) == 0u) { if (xb_ld(&bar[XB_TMO])) break; if (sp > XB_SPIN_CAP) { if (lane == 0u) atomicAdd(&bar[XB_TMO], 1u); break; } }
    }
    const unsigned cnt = (unsigned)__popcll(__builtin_amdgcn_ballot_w64(c > 0u));
    const unsigned mine = (unsigned)__shfl((int)c, (int)x);
    if (lane == 0u) { st[0] = mine > 0u ? mine : 1u; st[1] = cnt > 0u ? cnt : 1u; }
}
DI void xcd_barrier(const XcdBarrier& b) {
    asm volatile("s_waitcnt vmcnt(0)" ::: "memory");
    __syncthreads();
    if (threadIdx.x == 0) {
        unsigned* bar = b.bar;
        __builtin_amdgcn_s_waitcnt(0);
        const unsigned nloc = b.st[0], nx = b.st[1];
        const unsigned old = xb_add(&bar[XB_XSUB(b.x)], 1u);
        const unsigned gen = old / nloc;
        if (old + 1u == (gen + 1u) * nloc) {
            __builtin_amdgcn_fence(__ATOMIC_RELEASE, "agent");
            asm volatile("s_waitcnt vmcnt(0)" ::: "memory");
            const unsigned og = xb_add(&bar[XB_TOP], 1u);
            const unsigned tg = og / nx;
            if (og + 1u == (tg + 1u) * nx) xb_add(&bar[XB_TOPGEN], 1u);
            else XB_SPIN(xb_ld(&bar[XB_TOPGEN]) == tg, bar);
            __builtin_amdgcn_fence(__ATOMIC_ACQUIRE, "agent");
            xb_add(&bar[XB_XGEN(b.x)], 1u);
            asm volatile("s_waitcnt vmcnt(0)" ::: "memory");
        } else {
            XB_SPIN(xb_ld(&bar[XB_XGEN(b.x)]) == gen, bar);
            __builtin_amdgcn_fence(__ATOMIC_ACQUIRE, "agent");
            asm volatile("s_waitcnt vmcnt(0)" ::: "memory");
        }
    }
    __syncthreads();
}

__global__ void __launch_bounds__(NTHREADS, 2) fwd_megakernel(Params P) {
    extern __shared__ __attribute__((aligned(16))) unsigned char lds_raw[];
    LAS unsigned char* lds = (LAS unsigned char*)lds_raw;
    { volatile LAS unsigned* st0 = (volatile LAS unsigned*)(lds + 143360); if (threadIdx.x < 2) st0[threadIdx.x] = 0u; }
    __syncthreads();
    (void)xcd_barrier_post((unsigned*)(P.ws + WS_BAR), (volatile LAS unsigned*)(lds + 143360));
#define GSYNC() do { XcdBarrier xb_; xb_.bar = (unsigned*)(P.ws + WS_BAR); xb_.x = xb_xcc_id(); xb_.st = (volatile LAS unsigned*)(lds + 143360); xcd_barrier(xb_); } while (0)
    unsigned char* ws = P.ws;
    const int G = gridDim.x, cid = blockIdx.x;

#ifndef SKIP_P0
    p0_prologue(P, lds);
#endif
    if (threadIdx.x < 64) xcd_barrier_census_wave((unsigned*)(P.ws + WS_BAR), xb_xcc_id(), (volatile LAS unsigned*)(lds + 143360));
    GSYNC();
#ifndef SKIP_P0B
    p0b_h0(P);
#endif
    GSYNC();

    const bf16_t* H = (const bf16_t*)(ws + WS_H);
    const float* mod = (const float*)(ws + WS_MOD);
#pragma nounroll
    for (int layer = 0; layer < 4; ++layer) {
        const int j = layer >> 1;
        EpiG2 E2; E2.x0 = layer == 0 ? P.x : nullptr; E2.rsrc = (const unsigned short*)P.out; E2.rdst = layer == 3 ? (unsigned short*)(ws + WS_H) : (unsigned short*)P.out;
        E2.xc0 = layer == 0 ? P.ctx : nullptr; E2.rc = (unsigned short*)(ws + WS_XC); E2.gate = mod + layer * 15360 + 2048;
        E2.rstat = (const float*)(ws + WS_RSTAT); E2.png = P.ln_g + (layer > 0 ? layer - 1 : 0) * DM; E2.pnb = P.ln_b + (layer > 0 ? layer - 1 : 0) * DM;
        const int nM2 = 64;
        if ((layer & 1) == 0) {
            unsigned char* wa = ws + WS_WA0 + (size_t)j * WA_SIZE;
            { pg8::VSched S; S.init(68, 24, 16, G, cid, H, wa + WA_UZ, wa + WA_V, 1024);
              EpiG1A E; E.UZ = (bf16_t*)(ws + WS_ACT + ACT_UZ); E.VT = (bf16_t*)(ws + WS_ACT + ACT_VTA); E.stat = (float*)(ws + WS_STAT);
#ifndef SKIP_G1A
              { int nrep = REPN_G1A; asm volatile("" : "+s"(nrep));
#pragma nounroll
                for (int rep = 0; rep < nrep; ++rep) pg8::gemm_phase<EpiG1A, true, true>(lds, 1024, S, E); }
#endif
            }
            GSYNC();
#ifndef SKIP_SM
            spatial_mix(P, j, lds);
#endif
            GSYNC();
            { pg8::VSched S; S.init(nM2, 4, 4, G, cid, ws + WS_ACT + ACT_UZ, wa + WA_OUT, nullptr, 2048);
#ifndef SKIP_G2
              pg8::gemm_phase<EpiG2, true, true>(lds, 2048, S, E2);
#endif
            }
            if (layer < 3) g2_ctx_small(P, lds, (const bf16_t*)(ws + WS_ACT + ACT_UZ) + (size_t)TL * 2048, (const bf16_t*)(wa + WA_OUT), 2048, E2);
            GSYNC();
        } else {
            unsigned char* wb = ws + WS_WB0 + (size_t)j * WB_SIZE;
            { pg8::VSched S; S.init(68, 10, 9, G, cid, H, wb + WB_QKZ, wb + WB_V, 1024);
              EpiG1B E; E.Q = (bf16_t*)(ws + WS_ACT + ACT_Q); E.Kb = (bf16_t*)(ws + WS_ACT + ACT_K); E.Z = (bf16_t*)(ws + WS_ACT + ACT_Z); E.VT = (bf16_t*)(ws + WS_ACT + ACT_VTB); E.rope = (const LAS float*)(lds + 131072);
              { const int ct = opaque_tid(); *(LAS u32x4*)(lds + 131072 + ct * 16) = *(const u32x4*)(ws + WS_ROPE + ct * 16); __syncthreads(); }
#ifndef SKIP_G1B
              { int nrep = REPN_G1B; asm volatile("" : "+s"(nrep));
#pragma nounroll
                for (int rep = 0; rep < nrep; ++rep) pg8::gemm_phase<EpiG1B, true, true>(lds, 1024, S, E); }
#endif
            }
            GSYNC();
#ifndef SKIP_ATT
            attn_phase(P, j, layer < 3, lds);
#ifdef REP_ATT
            attn_phase(P, j, layer < 3, lds);
#endif
#endif
            GSYNC();
            { pg8::VSched S; S.init(nM2, 4, 4, G, cid, ws + WS_ACT + ACT_OZ, wb + WB_OUT, nullptr, 1024);
#ifndef SKIP_G2
              pg8::gemm_phase<EpiG2, true, true>(lds, 1024, S, E2);
#endif
            }
            if (layer < 3) g2_ctx_small(P, lds, (const bf16_t*)(ws + WS_ACT + ACT_OZ) + (size_t)TL * 1024, (const bf16_t*)(wb + WB_OUT), 1024, E2);
            GSYNC();
        }
#ifndef SKIP_LN
        ln_phase(P, layer);
#endif
        if (layer < 3) GSYNC();
#ifdef REP_SYNC
        GSYNC(); GSYNC(); GSYNC(); GSYNC();
#endif
    }
}

extern "C" void kernel_launch(void* const* d_in, const int* in_sizes, int n_in, void* d_out, int out_size, void* d_ws, size_t ws_size, hipStream_t stream) {
    static int grid = 0;
    if (grid == 0) {
        if (n_in != 17 || out_size != TL * DM || ws_size < WS_END) { fprintf(stderr, "kernel_launch: unexpected shapes (n_in %d out %d ws %zu)\n", n_in, out_size, ws_size); grid = -1; return; }
        int dev = 0, cus = 0, per_cu = 0;
        hipGetDevice(&dev);
        hipDeviceGetAttribute(&cus, hipDeviceAttributeMultiprocessorCount, dev);
        hipFuncSetAttribute((const void*)fwd_megakernel, hipFuncAttributeMaxDynamicSharedMemorySize, LDS_BYTES);
        hipOccupancyMaxActiveBlocksPerMultiprocessor(&per_cu, (const void*)fwd_megakernel, NTHREADS, LDS_BYTES);
        if (per_cu < 1) { fprintf(stderr, "kernel_launch: occupancy query says %d blocks/CU\n", per_cu); per_cu = 1; }
        grid = cus * per_cu;
        fprintf(stderr, "kernel_launch: cus %d per_cu %d grid %d\n", cus, per_cu, grid);
    }
    if (grid < 0) return;
    Params p{};
    p.x = (const float*)d_in[0]; p.c = (const float*)d_in[1]; p.ctx = (const float*)d_in[2]; p.c_ctx = (const float*)d_in[3];
    p.ada_w = (const float*)d_in[4]; p.ada_b = (const float*)d_in[5]; p.ln_g = (const float*)d_in[6]; p.ln_b = (const float*)d_in[7];
    p.a_w_in = (const float*)d_in[8]; p.a_ln_g = (const float*)d_in[9]; p.a_ln_b = (const float*)d_in[10]; p.a_w_s = (const float*)d_in[11]; p.a_b_s = (const float*)d_in[12]; p.a_w_out = (const float*)d_in[13];
    p.b_w_in = (const float*)d_in[14]; p.b_sink = (const float*)d_in[15]; p.b_w_out = (const float*)d_in[16];
    p.out = (float*)d_out; p.ws = (unsigned char*)d_ws;
    (void)hipMemsetAsync((char*)d_ws + WS_BAR, 0, XCD_BAR_WORDS * 4, stream);
    void* args[] = {&p};
    hipError_t e = hipLaunchCooperativeKernel((const void*)fwd_megakernel, dim3(grid), dim3(NTHREADS), args, LDS_BYTES, stream);
    if (e != hipSuccess) fprintf(stderr, "cooperative launch failed: %s (grid %d)\n", hipGetErrorString(e), grid);
}
```
